# Optimizing an MI355X kernel written in HIP

```python
import math
import jax
import jax.numpy as jnp
from jax import lax
import numpy as np

D_MODEL = 1024
BATCH = 1
SEQ = 16384
DEPTH = 1

CHUNK = 64
Q_BLOCK = 128
A_HEADS = 8
A_HEAD_DIM = 64
B_HEADS = 8
B_HEAD_DIM = 128
IDX_HEADS = 16
IDX_DIM = 64
TOPK_MAX = 256
N_EXPERTS = 32
TOP_K = 4
D_FF = 1024
SWIGLU_ALPHA = 1.702
SWIGLU_LIMIT = 7.0
MOE_BLOCK = 128
LN_EPS = 1e-5
DEEPNORM_ALPHA = (2.0 * DEPTH) ** 0.25
DEEPNORM_BETA = (8.0 * DEPTH) ** -0.25

A_QK = A_HEADS * 2 * A_HEAD_DIM
A_V = A_HEADS * 2 * A_HEAD_DIM
B_W = B_HEADS * B_HEAD_DIM
IDX_Q = IDX_HEADS * IDX_DIM
SPLIT_SIZES = (A_QK, A_QK, A_V, B_W, B_W, B_W, IDX_Q, IDX_DIM, IDX_HEADS, D_MODEL, D_MODEL)
SPLIT_POINTS = tuple(int(v) for v in np.cumsum(SPLIT_SIZES)[:-1])
PROJ_WIDTH = int(sum(SPLIT_SIZES))

kernel_name = 'hybrid_diffattn_dsa_moe_block'


def alibi_slopes(n):
    return 2.0 ** (-8.0 * jnp.arange(1, n + 1, dtype=jnp.float32) / n)


def chunk_end(pos):
    return (pos // CHUNK + 1) * CHUNK


def layer_norm(x, g=None, b=None):
    xf = x.astype(jnp.float32)
    mu = jnp.mean(xf, axis=-1, keepdims=True)
    var = jnp.mean(jnp.square(xf - mu), axis=-1, keepdims=True)
    y = (xf - mu) * lax.rsqrt(var + LN_EPS)
    if g is not None:
        y = y * g.astype(jnp.float32) + b.astype(jnp.float32)
    return y.astype(x.dtype)


def diff_attention(q, k, v, lam, lam_init, norm_g):
    B, S, H, _, d = q.shape
    nb = S // Q_BLOCK
    slopes = alibi_slopes(H)
    kpos = jnp.arange(S)
    scale = d ** -0.5

    def block(i):
        q_blk = lax.dynamic_slice_in_dim(q, i * Q_BLOCK, Q_BLOCK, axis=1)
        qpos = i * Q_BLOCK + jnp.arange(Q_BLOCK)
        s = jnp.einsum('bqhcd,bkhcd->bhcqk', q_blk, k, preferred_element_type=jnp.float32) * scale
        dist = jnp.abs(qpos[:, None] - kpos[None, :]).astype(jnp.float32)
        allowed = kpos[None, :] < chunk_end(qpos)[:, None]
        s = jnp.where(allowed, s - slopes[:, None, None, None] * dist, -jnp.inf)
        p = jax.nn.softmax(s, axis=-1)
        w = p[:, :, 0] - lam * p[:, :, 1]
        return jnp.einsum('bhqk,bkhe->bqhe', w.astype(v.dtype), v)

    o = lax.map(block, jnp.arange(nb))
    o = jnp.moveaxis(o, 0, 1).reshape(B, S, H, 2 * d)
    of = o.astype(jnp.float32)
    of = of * lax.rsqrt(jnp.mean(jnp.square(of), axis=-1, keepdims=True) + LN_EPS)
    of = of * norm_g.astype(jnp.float32) * (1.0 - lam_init)
    return of.astype(v.dtype).reshape(B, S, H * 2 * d)


def dsa_attention(q, k, v, qi, ki, wi):
    B, S, H, E = q.shape
    nb = S // Q_BLOCK
    topk = min(TOPK_MAX, S // 4)
    slopes = alibi_slopes(H)
    kpos = jnp.arange(S)
    gather = jax.vmap(lambda a, j: a[j])

    def block(i):
        sl = lambda a: lax.dynamic_slice_in_dim(a, i * Q_BLOCK, Q_BLOCK, axis=1)
        q_blk, qi_blk, wi_blk = sl(q), sl(qi), sl(wi)
        qpos = i * Q_BLOCK + jnp.arange(Q_BLOCK)
        end = chunk_end(qpos)
        allowed = kpos[None, :] < end[:, None]
        logits = jnp.einsum('bqgd,bkd->bqgk', qi_blk, ki, preferred_element_type=jnp.float32) * (IDX_DIM ** -0.5)
        w_h = wi_blk.astype(jnp.float32) * (IDX_HEADS ** -0.5)
        score = jnp.einsum('bqg,bqgk->bqk', w_h, jax.nn.relu(logits))
        score = jnp.where(allowed, score, -jnp.inf)
        _, idx = lax.top_k(score, topk)
        valid = idx < end[None, :, None]
        k_sel = gather(k, idx)
        v_sel = gather(v, idx)
        s = jnp.einsum('bqhe,bqkhe->bhqk', q_blk, k_sel, preferred_element_type=jnp.float32) * (E ** -0.5)
        dist = jnp.abs(qpos[None, :, None] - idx).astype(jnp.float32)
        s = s - slopes[None, :, None, None] * dist[:, None]
        s = jnp.where(valid[:, None], s, -jnp.inf)
        p = jax.nn.softmax(s, axis=-1)
        return jnp.einsum('bhqk,bqkhe->bqhe', p.astype(v.dtype), v_sel)

    o = lax.map(block, jnp.arange(nb))
    return jnp.moveaxis(o, 0, 1).reshape(B, S, H * E)


def moe_ffn(h, w_r, b_r, w1, b1, w2, b2):
    B, S, D = h.shape
    t = h.reshape(-1, D)
    logits = jnp.matmul(t, w_r, preferred_element_type=jnp.float32) + b_r.astype(jnp.float32)
    vals, idx = lax.top_k(logits, TOP_K)
    wts = jax.nn.softmax(vals, axis=-1)
    gate = jnp.einsum('nk,nke->ne', wts, jax.nn.one_hot(idx, N_EXPERTS, dtype=jnp.float32)).astype(t.dtype)
    n = t.shape[0]
    nb = n // MOE_BLOCK
    tb = t.reshape(nb, MOE_BLOCK, D)
    gb = gate.reshape(nb, MOE_BLOCK, N_EXPERTS)

    def block(args):
        xb, g = args
        u = jnp.einsum('td,edf->tef', xb, w1) + b1
        x_glu = jnp.minimum(u[..., 0::2], SWIGLU_LIMIT)
        x_lin = jnp.clip(u[..., 1::2], -SWIGLU_LIMIT, SWIGLU_LIMIT)
        a = x_glu * jax.nn.sigmoid(SWIGLU_ALPHA * x_glu) * (x_lin + 1.0)
        a = a * g[:, :, None]
        return jnp.einsum('tef,efd->td', a, w2) + jnp.matmul(g, b2)

    y = lax.map(block, (tb, gb))
    return y.reshape(B, S, D)


def setup_inputs(seed: int = 0) -> dict:
    key = jax.random.key(seed)
    ks = jax.random.split(key, 24)
    D = D_MODEL
    nrm = lambda k, shape, s: jax.random.normal(k, shape, jnp.float32) * s
    return {
        'x': nrm(ks[0], (BATCH, SEQ, D), 1.0),
        'c': nrm(ks[1], (BATCH, D), 1.0),
        'w_ada': nrm(ks[2], (DEPTH, D, 6 * D), 0.5 * D ** -0.5),
        'b_ada': nrm(ks[3], (DEPTH, 6 * D), 0.02),
        'w_in': nrm(ks[4], (DEPTH, D, PROJ_WIDTH), D ** -0.5),
        'lam_q1': nrm(ks[5], (DEPTH, A_HEAD_DIM), 0.1),
        'lam_k1': nrm(ks[6], (DEPTH, A_HEAD_DIM), 0.1),
        'lam_q2': nrm(ks[7], (DEPTH, A_HEAD_DIM), 0.1),
        'lam_k2': nrm(ks[8], (DEPTH, A_HEAD_DIM), 0.1),
        'diff_norm_g': 1.0 + nrm(ks[9], (DEPTH, 2 * A_HEAD_DIM), 0.02),
        'w_branch_a': nrm(ks[10], (DEPTH, A_V, D), A_V ** -0.5),
        'w_branch_b': nrm(ks[11], (DEPTH, B_W, D), B_W ** -0.5),
        'w_out': nrm(ks[12], (DEPTH, D, D), DEEPNORM_BETA * D ** -0.5),
        'ln1_g': 1.0 + nrm(ks[13], (DEPTH, D), 0.02),
        'ln1_b': nrm(ks[14], (DEPTH, D), 0.02),
        'w_router': nrm(ks[15], (DEPTH, D, N_EXPERTS), D ** -0.5),
        'b_router': nrm(ks[16], (DEPTH, N_EXPERTS), 0.01),
        'w_e1': nrm(ks[17], (DEPTH, N_EXPERTS, D, 2 * D_FF), D ** -0.5),
        'b_e1': nrm(ks[18], (DEPTH, N_EXPERTS, 2 * D_FF), 0.01),
        'w_e2': nrm(ks[19], (DEPTH, N_EXPERTS, D_FF, D), DEEPNORM_BETA * D_FF ** -0.5),
        'b_e2': nrm(ks[20], (DEPTH, N_EXPERTS, D), 0.01),
        'ln2_g': 1.0 + nrm(ks[21], (DEPTH, D), 0.02),
        'ln2_b': nrm(ks[22], (DEPTH, D), 0.02),
    }


def reference(x, c, w_ada, b_ada, w_in, lam_q1, lam_k1, lam_q2, lam_k2, diff_norm_g,
              w_branch_a, w_branch_b, w_out, ln1_g, ln1_b, w_router, b_router,
              w_e1, b_e1, w_e2, b_e2, ln2_g, ln2_b):
    B, S, D = x.shape
    c_act = jax.nn.silu(c)
    for l in range(DEPTH):
        mod = jnp.matmul(c_act, w_ada[l]) + b_ada[l]
        sh_a, sc_a, g_a, sh_f, sc_f, g_f = [m[:, None, :] for m in jnp.split(mod, 6, axis=-1)]

        u = layer_norm(x) * (1.0 + sc_a) + sh_a
        proj = jnp.matmul(u, w_in[l])
        (qa, ka, va, qb, kb, vb, qi, ki, wi, ga, gb) = jnp.split(proj, SPLIT_POINTS, axis=-1)

        lam_init = 0.8 - 0.6 * math.exp(-0.3 * l)
        lam = (jnp.exp(jnp.sum(lam_q1[l].astype(jnp.float32) * lam_k1[l].astype(jnp.float32)))
               - jnp.exp(jnp.sum(lam_q2[l].astype(jnp.float32) * lam_k2[l].astype(jnp.float32)))
               + lam_init)
        ya = diff_attention(qa.reshape(B, S, A_HEADS, 2, A_HEAD_DIM),
                            ka.reshape(B, S, A_HEADS, 2, A_HEAD_DIM),
                            va.reshape(B, S, A_HEADS, 2 * A_HEAD_DIM),
                            lam, lam_init, diff_norm_g[l])
        yb = dsa_attention(qb.reshape(B, S, B_HEADS, B_HEAD_DIM),
                           kb.reshape(B, S, B_HEADS, B_HEAD_DIM),
                           vb.reshape(B, S, B_HEADS, B_HEAD_DIM),
                           qi.reshape(B, S, IDX_HEADS, IDX_DIM), ki, wi)
        merged = (jax.nn.sigmoid(ga) * jnp.matmul(ya, w_branch_a[l])
                  + jax.nn.sigmoid(gb) * jnp.matmul(yb, w_branch_b[l]))
        mix_out = jnp.matmul(merged, w_out[l])
        x = layer_norm(DEEPNORM_ALPHA * x + g_a * mix_out, ln1_g[l], ln1_b[l])

        v = layer_norm(x) * (1.0 + sc_f) + sh_f
        ffn_out = moe_ffn(v, w_router[l], b_router[l], w_e1[l], b_e1[l], w_e2[l], b_e2[l])
        x = layer_norm(DEEPNORM_ALPHA * x + g_f * ffn_out.astype(x.dtype), ln2_g[l], ln2_b[l])
    return x
```

```cpp
#include <hip/hip_runtime.h>
#include <hip/hip_bf16.h>
#include <cstdio>
#include <cstdint>
#include <cmath>

#ifndef MK_ONE_LAUNCH
#define MK_ONE_LAUNCH 1
#endif

#ifndef PROBE_DUP
#define PROBE_DUP -1
#endif
namespace pg8 {
#define PG8_LAS __attribute__((address_space(3)))
typedef unsigned short bf16_t;
typedef short bf16x8 __attribute__((ext_vector_type(8)));
typedef float f32x4 __attribute__((ext_vector_type(4)));
typedef unsigned u32x4 __attribute__((ext_vector_type(4)));
typedef int i32x4_t __attribute__((ext_vector_type(4)));
typedef int i32x8_t __attribute__((ext_vector_type(8)));
constexpr int BM = 256, BK = 64, HALF = 128, HTB = HALF * BK * 2  , STAGE_BYTES = 8 * HTB, NXCD = 8, WGM = 8;

__host__ __device__ __forceinline__ int lds_byte(int r, int c) { const int st = (r >> 4) * 2 + (c >> 5), rr = r & 15, cc = c & 31, ob = rr * 64 + cc * 2; return st * 1024 + (ob ^ (((ob >> 9) & 1) << 5)); }
__host__ __device__ __forceinline__ void stage_rc(int b, int& R, int& C) { const int st = b / 1024, sb = b % 1024, swz = sb ^ (((sb >> 9) & 1) << 5); R = (st >> 1) * 16 + swz / 64; C = (st & 1) * 32 + (swz % 64) / 2; }
__host__ __device__ __forceinline__ int perm32(int rho) { const int n = rho >> 4, i = rho & 15; return 8 * (i >> 2) + 4 * n + (i & 3); }

struct Unit { int pm, pn; };
struct Gemm { const bf16_t* A; const bf16_t* Bt; int M, N, K; };

struct StaticOrder {
    int nM, nN, nwg, G, c;
    __host__ __device__ void init(int M, int N, int G_, int c_) { nM = M / BM; nN = N / BM; nwg = nM * nN; G = G_; c = c_; }
    __host__ __device__ bool next(int i, Unit& u) const { return at((long)i * G + c, u); }
    __host__ __device__ bool at(long L, Unit& u) const {
        if (L >= nwg) return false;
        int wgid = (int)L; { const int q = nwg / NXCD, r = nwg % NXCD, xcd = wgid % NXCD, off = wgid / NXCD; wgid = (xcd < r ? xcd * (q + 1) : r * (q + 1) + (xcd - r) * q) + off; }
        const int nig = WGM * nN, gid = wgid / nig, fm = gid * WGM, gsz = (nM - fm) < WGM ? (nM - fm) : WGM;
        u.pm = fm + ((wgid % nig) % gsz); u.pn = (wgid % nig) / gsz; return true;
    }
    __device__ __forceinline__ void a_ready(const Unit&) const {}
    __device__ __forceinline__ void done(const Unit&) const {}
};

__device__ __forceinline__ unsigned cvt_pk_bf16(float lo, float hi) { unsigned r; asm volatile("v_cvt_pk_bf16_f32 %0, %1, %2" : "=v"(r) : "v"(lo), "v"(hi)); return r; }
typedef float f32x2 __attribute__((ext_vector_type(2)));
template <class Epi, class Sched, bool ALIGN_EPI = false, bool SP2 = false, bool FP8 = false, bool GATHER = false>
__device__ __forceinline__ void gemm_phase(PG8_LAS unsigned char* lds, const Gemm g, const Sched& S, const Epi& E) {
    const int tid = threadIdx.x, wid = __builtin_amdgcn_readfirstlane(tid >> 6), lane = tid & 63, wr = wid >> 2, wc = wid & 3, fr = lane & 15, fq = lane >> 4;
    const int K = g.K; int nt_ = K / BK; if constexpr (FP8) asm volatile("" : "+s"(nt_));
    const int nt = nt_;
    static_assert(!GATHER || SP2, "GATHER is written for the SP2 loop");
    unsigned voffA[2], voffB[2]; int rowA[2]; unsigned colA[2];
#pragma unroll
    for (int i = 0; i < 2; ++i) { int R, C; stage_rc(tid * 16 + i * 8192, R, C); const int Rb = Epi::PERM ? ((R & ~31) + perm32(R & 31)) : R;
        voffA[i] = (unsigned)(R * K + C) * 2u; voffB[i] = (unsigned)(Rb * K + C) * 2u; rowA[i] = R; colA[i] = (unsigned)C * 2u; }
    const unsigned rowbytes = (unsigned)K * 2u;
    unsigned gC[2][2], tokN[2][2];
#define PG8_GLOAD(u_) do { _Pragma("unroll") for (int h_ = 0; h_ < 2; ++h_) _Pragma("unroll") for (int i_ = 0; i_ < 2; ++i_) { const int* p_ = S.row_ptr(u_, h_ * HALF + rowA[i_]); \
        asm volatile("global_load_dword %0, %1, off" : "=v"(tokN[h_][i_]) : "v"(p_) : "memory"); } } while (0)
#define PG8_GSETTLE() do { asm volatile("" : "+v"(tokN[0][0]), "+v"(tokN[0][1]), "+v"(tokN[1][0]), "+v"(tokN[1][1])); \
        _Pragma("unroll") for (int h_ = 0; h_ < 2; ++h_) _Pragma("unroll") for (int i_ = 0; i_ < 2; ++i_) gN[h_][i_] = tokN[h_][i_] * rowbytes + colA[i_]; } while (0)
#define PG8_STGA(b_, h_, kp_, ko_, G_) do { if constexpr (GATHER) PG8_STAGE(PG8_SA(b_, h_), (const char*)g.A + (ko_), G_[h_]); else PG8_STAGE(PG8_SA(b_, h_), (kp_) + (h_) * hstep, voffA); } while (0)
    const size_t kstep = (size_t)(BK * 2);
    const size_t hstep = (size_t)HALF * K * 2;
    const size_t tstep = 2 * hstep;
    const unsigned ldsw = (unsigned)wid * 1024u;
    const int aoff = lds_byte(wr * 64 + fr, fq * 8), boff = lds_byte(wc * 32 + fr, fq * 8);
#define PG8_SA(b, h) (((b) * 2 + (h)) * HTB)
#define PG8_SB(b, h) ((4 + (b) * 2 + (h)) * HTB)
#define PG8_STAGE(bufoff, gbase, voff) do { _Pragma("unroll") for (int _i = 0; _i < 2; ++_i) \
        __builtin_amdgcn_global_load_lds((const unsigned*)((const char*)(gbase) + (voff)[_i]), (PG8_LAS unsigned*)(lds + (bufoff) + ldsw + _i * 8192), 16, 0, 0); } while (0)
#define PG8_LD8(off_) __builtin_shufflevector(*(const PG8_LAS i32x4_t*)(lds + (off_)), *(const PG8_LAS i32x4_t*)(lds + (off_) + 1024), 0, 1, 2, 3, 4, 5, 6, 7)
#define PG8_LDA(dst, b, h) do { _Pragma("unroll") for (int m = 0; m < 4; ++m) { if constexpr (FP8) dst##8[m] = PG8_LD8(PG8_SA(b, h) + aoff + m * 2048); \
        else { _Pragma("unroll") for (int k = 0; k < 2; ++k) dst[m][k] = *(const PG8_LAS bf16x8*)(lds + PG8_SA(b, h) + aoff + m * 2048 + k * 1024); } } } while (0)
#define PG8_LDB(dst, b, h) do { _Pragma("unroll") for (int n = 0; n < 2; ++n) { if constexpr (FP8) dst##8[n] = PG8_LD8(PG8_SB(b, h) + boff + n * 2048); \
        else { _Pragma("unroll") for (int k = 0; k < 2; ++k) dst[n][k] = *(const PG8_LAS bf16x8*)(lds + PG8_SB(b, h) + boff + n * 2048 + k * 1024); } } } while (0)
#define PG8_MMA(ai, bj, At, Bt) do { __builtin_amdgcn_s_setprio(1); _Pragma("unroll") for (int m = 0; m < 4; ++m) _Pragma("unroll") for (int n = 0; n < 2; ++n) { \
        if constexpr (FP8) asm volatile("v_mfma_scale_f32_16x16x128_f8f6f4 %0, %1, %2, %0, %3, %3 op_sel_hi:[0,0,0]" : "+v"(acc[ai][bj][m][n]) : "v"(Bt##8[n]), "v"(At##8[m]), "v"(fp8_unit_scale));   \
        else { _Pragma("unroll") for (int k = 0; k < 2; ++k) acc[ai][bj][m][n] = __builtin_amdgcn_mfma_f32_16x16x32_bf16(Bt[n][k], At[m][k], acc[ai][bj][m][n], 0, 0, 0); } } \
        __builtin_amdgcn_s_setprio(0); } while (0)
#define PG8_WAIT_V(n) asm volatile("s_waitcnt vmcnt(" #n ")" ::: "memory")
#define PG8_WAIT_L(n) asm volatile("s_waitcnt lgkmcnt(" #n ")" ::: "memory")
#define PG8_BAR __builtin_amdgcn_s_barrier()
#define PG8_SCHED __builtin_amdgcn_sched_barrier(0)
    Unit cur, nxt; int ui = 0;
    if (!S.next(0, cur)) return;
    f32x4 acc[2][2][4][2];
#pragma unroll
    for (int a = 0; a < 2; ++a)
#pragma unroll
        for (int b = 0; b < 2; ++b)
#pragma unroll
            for (int m = 0; m < 4; ++m)
#pragma unroll
                for (int n = 0; n < 2; ++n) acc[a][b][m][n] = (f32x4){0.f, 0.f, 0.f, 0.f};
    int fp8_unit_scale = 0x7f7f7f7f; asm volatile("" : "+v"(fp8_unit_scale));
    bf16x8 At[4][2], B0[2][2], B1[2][2]; i32x8_t At8[4], B08[2], B18[2];
    const char* cA = (const char*)g.A + (size_t)cur.pm * tstep; const char* cB = (const char*)g.Bt + (size_t)cur.pn * tstep;
    S.a_ready(cur);
    if constexpr (SP2) {
        if constexpr (GATHER) { unsigned gN[2][2]; PG8_GLOAD(cur); asm volatile("s_waitcnt vmcnt(0)" ::: "memory"); PG8_GSETTLE();
#pragma unroll
            for (int h_ = 0; h_ < 2; ++h_) { gC[h_][0] = gN[h_][0]; gC[h_][1] = gN[h_][1]; } }
        PG8_STAGE(PG8_SB(0, 0), cB, voffB); PG8_STAGE(PG8_SB(0, 1), cB + hstep, voffB); PG8_STGA(0, 0, cA, 0, gC); PG8_STGA(0, 1, cA, 0, gC);
        if (wr == 1) PG8_BAR;
        PG8_WAIT_V(2); PG8_BAR;
        PG8_STAGE(PG8_SB(1, 0), cB + kstep, voffB); PG8_STGA(1, 0, cA + kstep, kstep, gC); PG8_STAGE(PG8_SB(1, 1), cB + hstep + kstep, voffB);
        PG8_WAIT_V(6); PG8_BAR;
    } else {
        PG8_STAGE(PG8_SB(0, 0), cB, voffB); PG8_STAGE(PG8_SA(0, 0), cA, voffA); PG8_STAGE(PG8_SB(0, 1), cB + hstep, voffB); PG8_STAGE(PG8_SA(0, 1), cA + hstep, voffA);
        if (wr == 1) PG8_BAR;
        PG8_WAIT_V(4); PG8_BAR;
        PG8_STAGE(PG8_SB(1, 0), cB + kstep, voffB); PG8_STAGE(PG8_SA(1, 0), cA + kstep, voffA); PG8_STAGE(PG8_SB(1, 1), cB + hstep + kstep, voffB);
        PG8_WAIT_V(6); PG8_BAR;
    }
    for (;;) {
        const bool has_next = S.next(ui + 1, nxt);
        const char* nA = has_next ? (const char*)g.A + (size_t)nxt.pm * tstep : cA; const char* nB = has_next ? (const char*)g.Bt + (size_t)nxt.pn * tstep : cB;
        if constexpr (GATHER) { if (has_next) PG8_GLOAD(nxt); }
        unsigned gN[2][2];
#pragma unroll
        for (int h_ = 0; h_ < 2; ++h_) { gN[h_][0] = gC[h_][0]; gN[h_][1] = gC[h_][1]; }
        for (int t = 0; t < nt; t += 2) {
            const bool last = (t == nt - 2);
            const size_t ko1 = (size_t)(t + 1) * kstep, ko2 = last ? 0 : (size_t)(t + 2) * kstep, ko3 = ko2 + kstep;
            unsigned gS[2][2];
            if constexpr (GATHER) { if (last && has_next) PG8_GSETTLE();
#pragma unroll
                for (int h_ = 0; h_ < 2; ++h_) { gS[h_][0] = last ? gN[h_][0] : gC[h_][0]; gS[h_][1] = last ? gN[h_][1] : gC[h_][1]; } }
            const char* a1 = cA + (size_t)(t + 1) * kstep;
            const char* a2 = last ? nA : cA + (size_t)(t + 2) * kstep; const char* b2 = last ? nB : cB + (size_t)(t + 2) * kstep;
            const char* a3 = a2 + kstep; const char* b3 = b2 + kstep;
            if (last && has_next) S.a_ready(nxt);
            if constexpr (SP2) {
            PG8_LDB(B0, 0, 0); PG8_LDB(B1, 0, 1); PG8_SCHED; PG8_LDA(At, 0, 0); PG8_STGA(1, 1, a1, ko1, gC);
            PG8_WAIT_V(8); PG8_WAIT_L(0); PG8_BAR; PG8_MMA(0, 0, At, B0); PG8_MMA(0, 1, At, B1); PG8_BAR; PG8_SCHED;
            PG8_LDA(At, 0, 1); PG8_STAGE(PG8_SB(0, 0), b2, voffB); PG8_STAGE(PG8_SB(0, 1), b2 + hstep, voffB); PG8_STGA(0, 0, a2, ko2, gS);
            PG8_WAIT_V(8); PG8_WAIT_L(0); PG8_BAR; PG8_MMA(1, 0, At, B0); PG8_MMA(1, 1, At, B1); PG8_BAR; PG8_SCHED;
            PG8_LDB(B0, 1, 0); PG8_LDB(B1, 1, 1); PG8_SCHED; PG8_LDA(At, 1, 0); PG8_STGA(0, 1, a2, ko2, gS);
            PG8_WAIT_V(8); PG8_WAIT_L(0); PG8_BAR; PG8_MMA(0, 0, At, B0); PG8_MMA(0, 1, At, B1); PG8_BAR; PG8_SCHED;
            PG8_LDA(At, 1, 1); PG8_STAGE(PG8_SB(1, 0), b3, voffB); PG8_STAGE(PG8_SB(1, 1), b3 + hstep, voffB); PG8_STGA(1, 0, a3, ko3, gS);
            PG8_WAIT_V(8); PG8_WAIT_L(0); PG8_BAR; PG8_MMA(1, 0, At, B0); PG8_MMA(1, 1, At, B1); PG8_BAR; PG8_SCHED;
            } else {
            PG8_LDB(B0, 0, 0); PG8_SCHED; PG8_LDA(At, 0, 0); PG8_STAGE(PG8_SA(1, 1), a1 + hstep, voffA);
            PG8_WAIT_L(8); PG8_BAR; PG8_WAIT_L(0); PG8_MMA(0, 0, At, B0); PG8_BAR; PG8_SCHED;
            PG8_LDB(B1, 0, 1); PG8_STAGE(PG8_SB(0, 0), b2, voffB);
            PG8_BAR; PG8_WAIT_L(0); PG8_MMA(0, 1, At, B1); PG8_BAR;
            PG8_LDA(At, 0, 1); PG8_STAGE(PG8_SA(0, 0), a2, voffA);
            PG8_BAR; PG8_WAIT_L(0); PG8_MMA(1, 0, At, B0); PG8_BAR; PG8_SCHED;
            PG8_STAGE(PG8_SB(0, 1), b2 + hstep, voffB);
            PG8_WAIT_V(6); PG8_BAR; PG8_MMA(1, 1, At, B1); PG8_BAR;
            PG8_LDB(B0, 1, 0); PG8_SCHED; PG8_LDA(At, 1, 0); PG8_STAGE(PG8_SA(0, 1), a2 + hstep, voffA);
            PG8_WAIT_L(8); PG8_BAR; PG8_WAIT_L(0); PG8_MMA(0, 0, At, B0); PG8_BAR; PG8_SCHED;
            PG8_LDB(B1, 1, 1); PG8_STAGE(PG8_SB(1, 0), b3, voffB);
            PG8_BAR; PG8_WAIT_L(0); PG8_MMA(0, 1, At, B1); PG8_BAR;
            PG8_LDA(At, 1, 1); PG8_STAGE(PG8_SA(1, 0), a3, voffA);
            PG8_BAR; PG8_WAIT_L(0); PG8_MMA(1, 0, At, B0); PG8_BAR; PG8_SCHED;
            PG8_STAGE(PG8_SB(1, 1), b3 + hstep, voffB);
            PG8_WAIT_V(6); PG8_BAR; PG8_MMA(1, 1, At, B1); PG8_BAR;
            }
        }
        if constexpr (ALIGN_EPI) { if (wr == 0) PG8_BAR; }
        if constexpr (FP8) asm volatile("s_nop 15\n\ts_nop 15" ::: "memory");
        if constexpr (!Epi::AFTER_DRAIN) { E(acc, cur, wr, wc, fr, fq); S.done(cur); }
        if (!has_next) break;
#pragma unroll
        for (int a = 0; a < 2; ++a)
#pragma unroll
            for (int b = 0; b < 2; ++b)
#pragma unroll
                for (int m = 0; m < 4; ++m)
#pragma unroll
                    for (int n = 0; n < 2; ++n) acc[a][b][m][n] = (f32x4){0.f, 0.f, 0.f, 0.f};
        cur = nxt; cA = nA; cB = nB; ++ui;
        if constexpr (GATHER) {
#pragma unroll
            for (int h_ = 0; h_ < 2; ++h_) { gC[h_][0] = gN[h_][0]; gC[h_][1] = gN[h_][1]; } }
        if constexpr (ALIGN_EPI) { if (wr == 1) PG8_BAR; }
    }
    PG8_WAIT_V(0);
    if constexpr (!ALIGN_EPI) { if (wr == 0) PG8_BAR; }
    PG8_BAR;
    if constexpr (Epi::AFTER_DRAIN) { E.fused(acc, cur, wr, wc, fr, fq, lds, wid, lane); S.done(cur); }
#undef PG8_SA
#undef PG8_SB
#undef PG8_STAGE
#undef PG8_GLOAD
#undef PG8_GSETTLE
#undef PG8_STGA
#undef PG8_LDA
#undef PG8_LDB
#undef PG8_MMA
#undef PG8_LD8
#undef PG8_WAIT_V
#undef PG8_WAIT_L
#undef PG8_BAR
#undef PG8_SCHED
}
}

#define GAS __attribute__((address_space(1)))
#define LAS __attribute__((address_space(3)))
typedef unsigned short bf16;
typedef unsigned v4u __attribute__((ext_vector_type(4)));
typedef unsigned v2u __attribute__((ext_vector_type(2)));
typedef float f32x4 __attribute__((ext_vector_type(4)));
typedef float f32x2 __attribute__((ext_vector_type(2)));
typedef GAS unsigned gu32;
#define RLX_AGENT __ATOMIC_RELAXED, __HIP_MEMORY_SCOPE_AGENT
#define LDS_WAIT() asm volatile("s_waitcnt lgkmcnt(0)" ::: "memory")
#define VM_WAIT() asm volatile("s_waitcnt vmcnt(0)" ::: "memory")
__device__ __forceinline__ unsigned f2bf(float f) { unsigned u = __builtin_bit_cast(unsigned, f); return (u + 0x7fffu + ((u >> 16) & 1u)) >> 16; }
__device__ __forceinline__ unsigned pk2(float lo, float hi) { unsigned r; asm("v_cvt_pk_bf16_f32 %0, %1, %2" : "=v"(r) : "v"(lo), "v"(hi)); return r; }
__device__ __forceinline__ float bflo(unsigned w) { return __builtin_bit_cast(float, w << 16); }
__device__ __forceinline__ float bfhi(unsigned w) { return __builtin_bit_cast(float, w & 0xffff0000u); }
__device__ __forceinline__ unsigned pk4_fp8(float a, float b, float c, float d) {
    int w = __builtin_amdgcn_cvt_pk_fp8_f32(a, b, 0, false); w = __builtin_amdgcn_cvt_pk_fp8_f32(c, d, w, true); return (unsigned)w; }
__device__ __forceinline__ float wave_sum(float v) {
#define WS_DPP(x, ctrl, rm, bc) __builtin_bit_cast(float, __builtin_amdgcn_update_dpp(0, __builtin_bit_cast(int, (x)), (ctrl), (rm), 0xf, (bc)))
    v += WS_DPP(v, 0x111, 0xf, true); v += WS_DPP(v, 0x112, 0xf, true); v += WS_DPP(v, 0x114, 0xf, true); v += WS_DPP(v, 0x118, 0xf, true);
    v += WS_DPP(v, 0x142, 0xa, false);
    v += WS_DPP(v, 0x143, 0xc, false);
#undef WS_DPP
    return __builtin_bit_cast(float, __builtin_amdgcn_readlane(__builtin_bit_cast(int, v), 63));
}
__device__ __forceinline__ float sigmoidf_fast(float x) { return __builtin_amdgcn_rcpf(1.f + __builtin_amdgcn_exp2f(-1.4426950408889634f * x)); }

#define XB_TMO      128
#define XB_XCNT(j)  (256  + 64 * (j))
#define XB_XSUB(j)  (1280 + 64 * (j))
#define XB_XGEN(j)  (2304 + 64 * (j))
#define XB_TOP      3328
#define XB_TOPGEN   3392
#define XCD_BAR_WORDS 3456
#define XB_SPIN_CAP (1u << 18)

__device__ __forceinline__ unsigned xb_ld(unsigned* p)              { return __hip_atomic_load(p, __ATOMIC_RELAXED, __HIP_MEMORY_SCOPE_AGENT); }
__device__ __forceinline__ unsigned xb_add(unsigned* p, unsigned v) { return __hip_atomic_fetch_add(p, v, __ATOMIC_RELAXED, __HIP_MEMORY_SCOPE_AGENT); }
__device__ __forceinline__ unsigned xb_xcc_id() { return (unsigned)__builtin_amdgcn_s_getreg((3 << 11) | 20) & 0xFu; }
#define XB_SPIN(cond, bar) do { unsigned _sp = 0; while (cond) { __builtin_amdgcn_s_sleep(1); \
    if ((++_sp & 255u) == 0u) { if (xb_ld(&(bar)[XB_TMO])) break; if (_sp > XB_SPIN_CAP) { atomicAdd(&(bar)[XB_TMO], 1u); break; } } } } while (0)

struct XcdBarrier {
    unsigned* bar; unsigned x;
    volatile LAS unsigned* st;
};

__device__ __forceinline__ XcdBarrier xcd_barrier_post(unsigned* bar, volatile LAS unsigned* st) {
    XcdBarrier b; b.bar = bar; b.x = xb_xcc_id(); b.st = st;
    if (threadIdx.x == 0) (void)xb_add(&bar[XB_XCNT(b.x)], 1u);
    return b;
}
__device__ __forceinline__ void xcd_barrier_complete(unsigned* bar, unsigned x, unsigned& nloc, unsigned& nx) {
    const unsigned G = gridDim.x * gridDim.y * gridDim.z;
    unsigned sum, cnt, mine, sp = 0u;
    for (;;) {
        sum = 0u; cnt = 0u; mine = 0u;
#pragma unroll
        for (unsigned j = 0; j < 16; ++j) { const unsigned c = xb_ld(&bar[XB_XCNT(j)]); sum += c; cnt += (c > 0u) ? 1u : 0u; mine = (j == x) ? c : mine; }
        if (sum == G) break;
        __builtin_amdgcn_s_sleep(1);
        if ((++sp & 255u) == 0u) { if (xb_ld(&bar[XB_TMO])) break; if (sp > XB_SPIN_CAP) { atomicAdd(&bar[XB_TMO], 1u); break; } }
    }
    nloc = mine > 0u ? mine : 1u; nx = cnt > 0u ? cnt : 1u;
}

__device__ __forceinline__ void xcd_barrier(const XcdBarrier& b) {
    asm volatile("s_waitcnt vmcnt(0)" ::: "memory");
    __syncthreads();
    if (threadIdx.x == 0) {
        unsigned* bar = b.bar;
        __builtin_amdgcn_s_waitcnt(0);
        unsigned nloc = b.st[0], nx = b.st[1];
        if (nloc == 0u) { xcd_barrier_complete(bar, b.x, nloc, nx); b.st[0] = nloc; b.st[1] = nx; }
        const unsigned old = xb_add(&bar[XB_XSUB(b.x)], 1u);
        const unsigned gen = old / nloc;
        if (old + 1u == (gen + 1u) * nloc) {
            __builtin_amdgcn_fence(__ATOMIC_RELEASE, "agent");
            asm volatile("s_waitcnt vmcnt(0)" ::: "memory");
            const unsigned og = xb_add(&bar[XB_TOP], 1u);
            const unsigned tg = og / nx;
            if (og + 1u == (tg + 1u) * nx) xb_add(&bar[XB_TOPGEN], 1u);
            else XB_SPIN(xb_ld(&bar[XB_TOPGEN]) == tg, bar);
            __builtin_amdgcn_fence(__ATOMIC_ACQUIRE, "agent");
            xb_add(&bar[XB_XGEN(b.x)], 1u);
            asm volatile("s_waitcnt vmcnt(0)" ::: "memory");
        } else {
            XB_SPIN(xb_ld(&bar[XB_XGEN(b.x)]) == gen, bar);
            __builtin_amdgcn_fence(__ATOMIC_ACQUIRE, "agent");
            asm volatile("s_waitcnt vmcnt(0)" ::: "memory");
        }
    }
    __syncthreads();
}

constexpr int NWAVES = 8;
constexpr int S = 16384, D = 1024, NE = 32, FF = 1024;
constexpr int NIN = 9296, NPROJ8 = 8192, NPROJ16 = 1280;
constexpr float WIN_FP8_SCALE = 32.f;
constexpr float O2_FP8_SCALE = 64.f;
constexpr float Y_FP8_SCALE = 8.f, WAB_FP8_SCALE = 32.f, MG_FP8_SCALE = 8.f, WO_FP8_SCALE = 64.f;
constexpr float LN_EPS = 1e-5f;
constexpr float ALPHA = 1.18920711500272f;
constexpr float LOG2E = 1.4426950408889634f;
constexpr float QA_SCALE = 0.125f * LOG2E;
constexpr float QB_SCALE = 0.08838834764831845f * LOG2E;
constexpr float WI_SCALE = 0.125f * 0.25f;
constexpr float LAM_INIT = 0.2f;
constexpr float W1_FP8_SCALE = 32.f, W2_FP8_SCALE = 64.f;

constexpr size_t MiB = 1u << 20;
constexpr size_t WS_CTL = 0, CTL_ZERO_BYTES = 1 * MiB;
constexpr size_t WS_SMALL = 1 * MiB;
constexpr size_t WS_WIN = 2 * MiB;
constexpr size_t WS_WIN8 = 6 * MiB;
constexpr size_t WS_WA = 21 * MiB, WS_WB = 23 * MiB, WS_WO = 25 * MiB;
constexpr size_t WS_W1 = 27 * MiB;
constexpr size_t WS_W2 = 155 * MiB;
constexpr size_t WS_X1 = 219 * MiB;
constexpr size_t WS_IDXTOK = WS_X1;
constexpr size_t WS_IDXW = WS_X1 + 4 * MiB;
constexpr size_t WS_Y1 = 283 * MiB;
constexpr size_t WS_VB16 = 347 * MiB;
constexpr size_t WS_TOKE = 379 * MiB;
constexpr size_t WS_TOKP = WS_TOKE + 256 * 1024;
constexpr size_t WS_TOKW = WS_TOKP + 256 * 1024;
constexpr size_t WS_TOKSLOT = WS_TOKW + 256 * 1024;
constexpr size_t WS_SLOTW = WS_TOKSLOT + 256 * 1024;
constexpr size_t WS_NSD = WS_SLOTW + 320 * 1024;
constexpr size_t WS_ERA = 381 * MiB;
constexpr size_t WS_U = WS_ERA;
constexpr size_t WS_PROJ = WS_ERA + 32 * MiB;
constexpr size_t PROJ_STRIDE = (size_t)S * D;
constexpr size_t WS_KI = WS_ERA + 320 * MiB;
constexpr size_t WS_WI = WS_ERA + 322 * MiB;
constexpr size_t WS_MASK = WS_ERA + 323 * MiB;
constexpr size_t WS_YA = WS_ERA + 355 * MiB, WS_YB = WS_ERA + 387 * MiB;
constexpr size_t WS_SCR = WS_ERA + 419 * MiB;
constexpr size_t WS_T1 = WS_ERA + 451 * MiB;
constexpr size_t WS_MG = WS_ERA + 515 * MiB;
constexpr int MAXSLOT = 73728;
constexpr size_t WS_XS = WS_ERA;
constexpr size_t WS_H = WS_ERA + 144 * MiB;
constexpr size_t WS_OUT2 = WS_ERA + 288 * MiB;
constexpr size_t WS_U8 = WS_ERA + 547 * MiB;
constexpr size_t WS_END = WS_ERA + 563 * MiB;
static_assert(WS_END <= 1024 * MiB, "workspace map");

constexpr int CW_BAR = 4096;
constexpr int CW_NRM = 9216;
constexpr int CW_BG = 9472, CW_DONE = 9536;
constexpr int CW_P0 = 9600;
constexpr int CW_Q3 = 8192, CW_Q4D = 8448, CW_Q4S = 8704, CW_ECNT = 8960;

constexpr int RING_OFF = 0, RING_BYTES = 131072;
constexpr int LDSCTL_OFF = 145408;
constexpr int MISC_OFF = LDSCTL_OFF + 320;
constexpr int L_CNT = LDSCTL_OFF + 1024;
constexpr int L_BASE = L_CNT + 128;
constexpr int L_OFF = L_BASE + 128;
constexpr int L_TEXP = L_OFF + 256;
constexpr int L_NT = L_TEXP + 320;
constexpr int L_QI = L_NT + 16;
constexpr int L_TINFO = L_QI + 16;
constexpr int L_ORDER = L_TINFO + 64 * 4 * 12;
constexpr int L_T0 = L_ORDER + 4096;
constexpr int LDS_BYTES = 161792;
static_assert(L_T0 + 2048 <= LDS_BYTES, "LDS map");

struct Args { const float* in[23]; float* out; unsigned char* ws; int ph_lo, ph_hi; };
typedef const __attribute__((address_space(4))) Args* KArgs;
__device__ __forceinline__ KArgs kargs() { KArgs p = (KArgs)__builtin_amdgcn_kernarg_segment_ptr(); asm volatile("" : "+s"(p)); return p; }
struct Frame {
    LAS unsigned char* lds;
    volatile LAS unsigned* MISC;
    gu32* ctl;
    int tid, lane, wave, G, bid;
    unsigned char* ws;
    KArgs ap;
};
#define FIN(F, k) ((F).ap->in[k])

namespace epi {
using pg8::Unit; using pg8::cvt_pk_bf16; using pg8::bf16_t; using pg8::HALF; using pg8::BM;
typedef pg8::f32x4 f4; typedef pg8::u32x4 u4; typedef unsigned u2 __attribute__((ext_vector_type(2)));

struct EpiProj8 {
    static constexpr bool PERM = true, AFTER_DRAIN = false;
    bf16_t* out;
    __device__ __forceinline__ void operator()(const f4 (&acc)[2][2][4][2], const Unit& u, int wr, int wc, int fr, int fq) const {
        const int row0 = u.pm * BM + wr * 64 + fr;
        const int tile = u.pn;
        const int buf = tile < 24 ? (tile >> 2) : 7 + ((tile - 24) >> 2);
        bf16_t* base = out + (size_t)buf * PROJ_STRIDE;
        const int col0 = (tile & 3) * 256 + wc * 32 + 8 * fq;
        const float sc = (1.f / WIN_FP8_SCALE) * ((buf == 0) ? QA_SCALE : ((buf == 3) ? QB_SCALE : 1.f));
        const bool sig = buf >= 7;
#pragma unroll
        for (int ai = 0; ai < 2; ++ai)
#pragma unroll
            for (int m = 0; m < 4; ++m) { bf16_t* rowp = base + (size_t)(row0 + ai * HALF + m * 16) * D + col0;
#pragma unroll
                for (int bj = 0; bj < 2; ++bj) { f4 v0 = acc[ai][bj][m][0] * sc, v1 = acc[ai][bj][m][1] * sc;
                    if (sig) {
#pragma unroll
                        for (int e = 0; e < 4; ++e) { v0[e] = sigmoidf_fast(v0[e]); v1[e] = sigmoidf_fast(v1[e]); }
                    }
                    u4 w; w.x = cvt_pk_bf16(v0[0], v0[1]); w.y = cvt_pk_bf16(v0[2], v0[3]); w.z = cvt_pk_bf16(v1[0], v1[1]); w.w = cvt_pk_bf16(v1[2], v1[3]);
                    *(u4*)(rowp + bj * HALF) = w; } }
    }
};
struct EpiProjIdx {
    static constexpr bool PERM = true, AFTER_DRAIN = false;
    bf16_t* qi; bf16_t* ki; float* wi;
    __device__ __forceinline__ void operator()(const f4 (&acc)[2][2][4][2], const Unit& u, int wr, int wc, int fr, int fq) const {
        const int row0 = u.pm * BM + wr * 64 + fr;
        const int tile = u.pn;
        if (tile < 4) {
            const int col0 = tile * 256 + wc * 32 + 8 * fq;
#pragma unroll
            for (int ai = 0; ai < 2; ++ai)
#pragma unroll
                for (int m = 0; m < 4; ++m) { bf16_t* rowp = qi + (size_t)(row0 + ai * HALF + m * 16) * D + col0;
#pragma unroll
                    for (int bj = 0; bj < 2; ++bj) { const f4 v0 = acc[ai][bj][m][0], v1 = acc[ai][bj][m][1];
                        u4 w; w.x = cvt_pk_bf16(v0[0], v0[1]); w.y = cvt_pk_bf16(v0[2], v0[3]); w.z = cvt_pk_bf16(v1[0], v1[1]); w.w = cvt_pk_bf16(v1[2], v1[3]);
                        *(u4*)(rowp + bj * HALF) = w; } }
        } else {
            const int c0 = wc * 32 + 8 * fq;
            if (wc < 2) {
#pragma unroll
                for (int ai = 0; ai < 2; ++ai)
#pragma unroll
                    for (int m = 0; m < 4; ++m) { const f4 v0 = acc[ai][0][m][0], v1 = acc[ai][0][m][1];
                        u4 w; w.x = cvt_pk_bf16(v0[0], v0[1]); w.y = cvt_pk_bf16(v0[2], v0[3]); w.z = cvt_pk_bf16(v1[0], v1[1]); w.w = cvt_pk_bf16(v1[2], v1[3]);
                        *(u4*)(ki + (size_t)(row0 + ai * HALF + m * 16) * 64 + c0) = w; }
            } else if (wc == 2 && fq < 2) {
#pragma unroll
                for (int ai = 0; ai < 2; ++ai)
#pragma unroll
                    for (int m = 0; m < 4; ++m) { float* p = wi + (size_t)(row0 + ai * HALF + m * 16) * 16 + (c0 - 64);
                        *(f4*)p = acc[ai][0][m][0] * WI_SCALE; *(f4*)(p + 4) = acc[ai][0][m][1] * WI_SCALE; }
            }
        }
    }
};

struct EpiGateA {
    static constexpr bool PERM = false, AFTER_DRAIN = false;
    const bf16_t* gate; float* t1;
    __device__ __forceinline__ void operator()(const f4 (&acc)[2][2][4][2], const Unit& u, int wr, int wc, int fr, int fq) const {
        const int col0 = u.pn * BM + wc * 32 + 4 * fq;
#pragma unroll
        for (int ai = 0; ai < 2; ++ai)
#pragma unroll
            for (int m = 0; m < 4; ++m) { const size_t off = (size_t)(u.pm * BM + ai * HALF + wr * 64 + m * 16 + fr) * D + col0;
#pragma unroll
                for (int bj = 0; bj < 2; ++bj)
#pragma unroll
                    for (int n = 0; n < 2; ++n) { const size_t o = off + bj * HALF + n * 16; const u2 g = *(const u2*)(gate + o);
                        f4 v = acc[ai][bj][m][n] * (1.f / (Y_FP8_SCALE * WAB_FP8_SCALE)); v[0] *= bflo(g.x); v[1] *= bfhi(g.x); v[2] *= bflo(g.y); v[3] *= bfhi(g.y);
                        *(f4*)(t1 + o) = v; } }
    }
};
struct EpiGateB {
    static constexpr bool PERM = false, AFTER_DRAIN = false;
    const bf16_t* gate; const float* t1; unsigned char* mg;
    __device__ __forceinline__ void operator()(const f4 (&acc)[2][2][4][2], const Unit& u, int wr, int wc, int fr, int fq) const {
        const int col0 = u.pn * BM + wc * 32 + 4 * fq;
#pragma unroll
        for (int ai = 0; ai < 2; ++ai)
#pragma unroll
            for (int m = 0; m < 4; ++m) { const size_t off = (size_t)(u.pm * BM + ai * HALF + wr * 64 + m * 16 + fr) * D + col0;
#pragma unroll
                for (int bj = 0; bj < 2; ++bj)
#pragma unroll
                    for (int n = 0; n < 2; ++n) { const size_t o = off + bj * HALF + n * 16; const u2 g = *(const u2*)(gate + o); const f4 t = *(const f4*)(t1 + o);
                        f4 v = acc[ai][bj][m][n] * (1.f / (Y_FP8_SCALE * WAB_FP8_SCALE)); v[0] = t[0] + v[0] * bflo(g.x); v[1] = t[1] + v[1] * bfhi(g.x); v[2] = t[2] + v[2] * bflo(g.y); v[3] = t[3] + v[3] * bfhi(g.y);
                        v = v * MG_FP8_SCALE; *(unsigned*)(mg + o) = pk4_fp8(v[0], v[1], v[2], v[3]); } }
    }
};
struct EpiOut {
    static constexpr bool PERM = false, AFTER_DRAIN = false;
    const float* x; const float* ga; bf16_t* y1;
    __device__ __forceinline__ void operator()(const f4 (&acc)[2][2][4][2], const Unit& u, int wr, int wc, int fr, int fq) const {
        const int col0 = u.pn * BM + wc * 32 + 4 * fq;
        f4 gv[2][2];
#pragma unroll
        for (int bj = 0; bj < 2; ++bj)
#pragma unroll
            for (int n = 0; n < 2; ++n) gv[bj][n] = *(const f4*)(ga + col0 + bj * HALF + n * 16);
#pragma unroll
        for (int ai = 0; ai < 2; ++ai)
#pragma unroll
            for (int m = 0; m < 4; ++m) { const size_t off = (size_t)(u.pm * BM + ai * HALF + wr * 64 + m * 16 + fr) * D + col0;
#pragma unroll
                for (int bj = 0; bj < 2; ++bj)
#pragma unroll
                    for (int n = 0; n < 2; ++n) { const size_t o = off + bj * HALF + n * 16; const f4 xv = *(const f4*)(x + o);
                        const f4 yv = xv * ALPHA + gv[bj][n] * (acc[ai][bj][m][n] * (1.f / (MG_FP8_SCALE * WO_FP8_SCALE)));
                        u2 w; w.x = cvt_pk_bf16(yv[0], yv[1]); w.y = cvt_pk_bf16(yv[2], yv[3]); *(u2*)(y1 + o) = w; } }
    }
};
struct EpiMoe1 {
    static constexpr bool PERM = true, AFTER_DRAIN = false;
    const float* b1; unsigned char* h;
    __device__ __forceinline__ void operator()(const f4 (&acc)[2][2][4][2], const Unit& u, int wr, int wc, int fr, int fq) const {
        const int e = u.pn >> 3, pnl = u.pn & 7;
        const int row0 = u.pm * BM + wr * 64 + fr;
        const int c0 = pnl * 256 + wc * 32 + 8 * fq;
        f4 bv[2][2];
#pragma unroll
        for (int bj = 0; bj < 2; ++bj)
#pragma unroll
            for (int n = 0; n < 2; ++n) bv[bj][n] = *(const f4*)(b1 + (size_t)e * 2048 + c0 + bj * HALF + 4 * n);
#pragma unroll
        for (int ai = 0; ai < 2; ++ai)
#pragma unroll
            for (int m = 0; m < 4; ++m) { unsigned char* rowp = h + (size_t)(row0 + ai * HALF + m * 16) * FF + (c0 >> 1);
#pragma unroll
                for (int bj = 0; bj < 2; ++bj) { const f4 v0 = acc[ai][bj][m][0] * (1.f / W1_FP8_SCALE) + bv[bj][0], v1 = acc[ai][bj][m][1] * (1.f / W1_FP8_SCALE) + bv[bj][1];
                    float a[4];
#pragma unroll
                    for (int p = 0; p < 4; ++p) { const float g = (p < 2) ? v0[2 * p] : v1[2 * p - 4], l = (p < 2) ? v0[2 * p + 1] : v1[2 * p - 3];
                        const float gl = fminf(g, 7.f), ll = fminf(fmaxf(l, -7.f), 7.f);
                        a[p] = gl * sigmoidf_fast(1.702f * gl) * (ll + 1.f); }
                    *(unsigned*)(rowp + bj * (HALF / 2)) = pk4_fp8(a[0], a[1], a[2], a[3]); } }
    }
};
struct EpiMoe2 {
    static constexpr bool PERM = true, AFTER_DRAIN = false;
    const float* b2; const float* idxw; const LAS unsigned* off; unsigned char* o2;
    __device__ __forceinline__ void operator()(const f4 (&acc)[2][2][4][2], const Unit& u, int wr, int wc, int fr, int fq) const {
        const int e = u.pn >> 2, pnl = u.pn & 3;
        const int row0 = u.pm * BM + wr * 64 + fr;
        const int c0 = pnl * 256 + wc * 32 + 8 * fq;
        f4 bv[2][2];
#pragma unroll
        for (int bj = 0; bj < 2; ++bj)
#pragma unroll
            for (int n = 0; n < 2; ++n) bv[bj][n] = *(const f4*)(b2 + (size_t)e * D + c0 + bj * HALF + 4 * n);
#pragma unroll
        for (int ai = 0; ai < 2; ++ai)
#pragma unroll
            for (int m = 0; m < 4; ++m) { const int row = row0 + ai * HALF + m * 16; const float gw = idxw[(size_t)e * S + (row - (int)off[e])] * O2_FP8_SCALE; unsigned char* rowp = o2 + (size_t)row * D + c0;
#pragma unroll
                for (int bj = 0; bj < 2; ++bj) { const f4 v0 = (acc[ai][bj][m][0] * (1.f / W2_FP8_SCALE) + bv[bj][0]) * gw, v1 = (acc[ai][bj][m][1] * (1.f / W2_FP8_SCALE) + bv[bj][1]) * gw;
                    u2 w; w.x = pk4_fp8(v0[0], v0[1], v0[2], v0[3]); w.y = pk4_fp8(v1[0], v1[1], v1[2], v1[3]);
                    *(u2*)(rowp + bj * HALF) = w; } }
    }
};
struct MoeOrder {
    const LAS unsigned char* texp; int ntiles, nN, G, c;
    const int* idxtok; const LAS unsigned* off; const LAS unsigned* cnt;
    __device__ __forceinline__ const int* row_ptr(const Unit& u, int r) const { const int e = (int)texp[u.pm]; const int p = (u.pm << 8) - (int)off[e] + r, c1 = (int)cnt[e] - 1; return idxtok + (size_t)e * S + (p < c1 ? p : c1); }
    __device__ __forceinline__ bool next(int i, Unit& u) const {
        const long L = (long)i * G + c; if (L >= (long)ntiles * nN) return false;
        const int pm = (int)(L / nN), pnl = (int)(L % nN);
        u.pm = pm; u.pn = (int)texp[pm] * nN + pnl; return true;
    }
    __device__ __forceinline__ void a_ready(const Unit&) const {}
    __device__ __forceinline__ void done(const Unit&) const {}
};
struct ProjOrder {
    pg8::StaticOrder s;
    __device__ __forceinline__ int count() const { return s.c < 64 ? 6 : s.c < 192 ? 9 : 8; }
    __device__ __forceinline__ bool next(int i, Unit& u) const {
        if (i < 6) return s.at((long)i * 256 + s.c, u);
        const int j = i - 6, x = s.c - 64;
        if (x < 0) return false;
        if (j < 2) return s.at(1536 + 192 * j + x, u);
        if (j == 2 && x < 128) return s.at(1920 + x, u);
        return false;
    }
    __device__ __forceinline__ void a_ready(const Unit&) const {}
    __device__ __forceinline__ void done(const Unit&) const {}
};
template <class Sd> struct RepOrder {
    Sd s; int n, reps;
    __device__ __forceinline__ bool next(int i, Unit& u) const { if (i >= n * reps) return false; return s.next(reps == 1 ? i : i % n, u); }
    __device__ __forceinline__ const int* row_ptr(const Unit& u, int r) const { return s.row_ptr(u, r); }
    __device__ __forceinline__ void a_ready(const Unit&) const {}
    __device__ __forceinline__ void done(const Unit&) const {}
};
}

namespace att {
using bf16x8 = __attribute__((ext_vector_type(8))) short;
using s16x4  = __attribute__((ext_vector_type(4))) short;
using f32x16 = __attribute__((ext_vector_type(16))) float;
using u32x4  = __attribute__((ext_vector_type(4))) unsigned;
constexpr int NW = 8, QBLK = 32, KVBLK = 64;
constexpr int SHM_V = 16384, SHM_K = 16384;
constexpr int L_V = 0, L_K = 2 * SHM_V, L_WS = 2 * SHM_V + 2 * SHM_K;
constexpr float THRL = 11.5f;
constexpr int KPF_DIFF = 2, KPF_DSA = 1;
constexpr int SDEPTH_DIFF = 2, SDEPTH_DSA = 1;
#define ASBAR() __builtin_amdgcn_sched_barrier(0)
__device__ __forceinline__ int crow(int r, int hi) { return (r & 3) + 8 * (r >> 2) + 4 * hi; }
__device__ __forceinline__ unsigned cvtpk(float lo, float hi) { unsigned r; asm volatile("v_cvt_pk_bf16_f32 %0, %1, %2" : "=v"(r) : "v"(lo), "v"(hi)); return r; }
template <int DQK> __device__ __forceinline__ int kswz(int row, int colB) {
    if constexpr (DQK == 128) return row * 256 + (colB ^ ((row & 7) << 4));
    else return row * 128 + (colB ^ (((row >> 1) & 7) << 4));
}
template <int DQK> __device__ __forceinline__ void qkt(f32x16& p0, f32x16& p1, const char* Ks, const bf16x8* qr, int r32, int hi) {
    p0 = f32x16{}; p1 = f32x16{};
#pragma unroll
    for (int d0 = 0; d0 < DQK / 16; ++d0) { const int cb = (d0 * 16 + hi * 8) * 2;
        const bf16x8 b0 = *reinterpret_cast<const bf16x8*>(Ks + kswz<DQK>(r32, cb));
        const bf16x8 b1 = *reinterpret_cast<const bf16x8*>(Ks + kswz<DQK>(32 + r32, cb));
        p0 = __builtin_amdgcn_mfma_f32_32x32x16_bf16(b0, qr[d0], p0, 0, 0, 0);
        p1 = __builtin_amdgcn_mfma_f32_32x32x16_bf16(b1, qr[d0], p1, 0, 0, 0); }
}
template <bool DSA> __device__ __forceinline__ void fixup_old(f32x16& p0, f32x16& p1, float qrel, float nslope, bool vis, unsigned mlo, unsigned mhi) {
    const float NEG = -__builtin_inff();
#pragma unroll
    for (int r = 0; r < 16; ++r) {
        const int bit = (r & 3) + 8 * (r >> 2);
        const float d0 = qrel - (float)bit, d1 = d0 - 32.f;
        const float s0 = __builtin_fmaf(__builtin_fabsf(d0), nslope, p0[r]);
        const float s1 = __builtin_fmaf(__builtin_fabsf(d1), nslope, p1[r]);
        bool k0 = vis, k1 = vis;
        if constexpr (DSA) { k0 = k0 && ((mlo >> bit) & 1u); k1 = k1 && ((mhi >> bit) & 1u); }
        p0[r] = k0 ? s0 : NEG; p1[r] = k1 ? s1 : NEG;
    }
}
__device__ __forceinline__ void partialSM_old(f32x16& p0, f32x16& p1, float& m_reg, float& mn, float& alpha) {
    float pmax = p0[0];
#pragma unroll
    for (int r = 1; r < 16; ++r) pmax = fmaxf(pmax, p0[r]);
#pragma unroll
    for (int r = 0; r < 16; ++r) pmax = fmaxf(pmax, p1[r]);
    { auto rr = __builtin_amdgcn_permlane32_swap(__float_as_uint(pmax), __float_as_uint(pmax), false, false);
      pmax = fmaxf(__uint_as_float(rr[0]), __uint_as_float(rr[1])); }
    if (__builtin_expect(__all(pmax - m_reg <= THRL), 1)) { mn = m_reg; alpha = 1.f; }
    else { mn = fmaxf(m_reg, pmax); alpha = __builtin_amdgcn_exp2f(m_reg - mn); m_reg = mn; }
#pragma unroll
    for (int r = 0; r < 16; ++r) { p0[r] = p0[r] - mn; p1[r] = p1[r] - mn; }
#pragma unroll
    for (int r = 0; r < 16; ++r) p0[r] = __builtin_amdgcn_exp2f(p0[r]);
}
template <bool DSA> __device__ __forceinline__ float msel(float v, unsigned mw, int bit) {
    if constexpr (DSA) { const unsigned m = (unsigned)__builtin_amdgcn_sbfe((int)mw, bit, 1); return __uint_as_float((__float_as_uint(v) & m) | (0xff800000u & ~m)); }
    else return v;
}
template <bool DSA> __device__ __forceinline__ void fix_fast(f32x16& p0, f32x16& p1, float sl, unsigned mlo, unsigned mhi) {
#pragma unroll
    for (int r = 0; r < 16; ++r) {
        const int bit = (r & 3) + 8 * (r >> 2);
        p0[r] = msel<DSA>(__builtin_fmaf(sl, (float)bit, p0[r]), mlo, bit);
        p1[r] = msel<DSA>(__builtin_fmaf(sl, (float)(bit + 32), p1[r]), mhi, bit);
    }
}
template <bool DSA> __device__ __forceinline__ void fix_slow(f32x16& p0, f32x16& p1, float qrel, float sl, bool vis, unsigned mlo, unsigned mhi) {
    const float NEG = -__builtin_inff();
#pragma unroll
    for (int r = 0; r < 16; ++r) {
        const int bit = (r & 3) + 8 * (r >> 2);
        const float d0 = qrel - (float)bit, d1 = d0 - 32.f;
        const float s0 = __builtin_fmaf(sl, qrel - __builtin_fabsf(d0), p0[r]);
        const float s1 = __builtin_fmaf(sl, qrel - __builtin_fabsf(d1), p1[r]);
        p0[r] = vis ? msel<DSA>(s0, mlo, bit) : NEG; p1[r] = vis ? msel<DSA>(s1, mhi, bit) : NEG;
    }
}
__device__ __forceinline__ void partialSM(f32x16& p0, f32x16& p1, float& m_reg, float& mn, float& alpha, float chi, float tau) {
    const float mloc = m_reg - tau;
    float pmax = p0[0];
#pragma unroll
    for (int r = 1; r < 16; ++r) pmax = fmaxf(pmax, p0[r]);
#pragma unroll
    for (int r = 0; r < 16; ++r) pmax = fmaxf(pmax, p1[r]);
    pmax += chi;
    { auto rr = __builtin_amdgcn_permlane32_swap(__float_as_uint(pmax), __float_as_uint(pmax), false, false);
      pmax = fmaxf(__uint_as_float(rr[0]), __uint_as_float(rr[1])); }
    pmax -= chi;
    if (__builtin_expect(__all(pmax - mloc <= THRL), 1)) { mn = mloc; alpha = 1.f; }
    else { mn = fmaxf(mloc, pmax); alpha = __builtin_amdgcn_exp2f(mloc - mn); }
    m_reg = mn + tau;
#pragma unroll
    for (int r = 0; r < 16; ++r) { p0[r] = p0[r] - mn; p1[r] = p1[r] - mn; }
#pragma unroll
    for (int r = 0; r < 16; ++r) p0[r] = __builtin_amdgcn_exp2f(p0[r]);
}
__device__ __forceinline__ void fixedSM(f32x16& p0, f32x16& p1, float mref) {
#pragma unroll
    for (int r = 0; r < 16; ++r) { p0[r] = p0[r] - mref; p1[r] = p1[r] - mref; }
#pragma unroll
    for (int r = 0; r < 16; ++r) p0[r] = __builtin_amdgcn_exp2f(p0[r]);
}
__device__ __forceinline__ void finishSM(f32x16& p0, f32x16& p1, float alpha, float& l_reg, bf16x8& pa0, bf16x8& pa1, bf16x8& pa2, bf16x8& pa3) {
#pragma unroll
    for (int r = 0; r < 16; ++r) p1[r] = __builtin_amdgcn_exp2f(p1[r]);
    float ps = 0;
#pragma unroll
    for (int r = 0; r < 16; ++r) ps += p0[r];
#pragma unroll
    for (int r = 0; r < 16; ++r) ps += p1[r];
    { auto rr = __builtin_amdgcn_permlane32_swap(__float_as_uint(ps), __float_as_uint(ps), false, false);
      ps = __uint_as_float(rr[0]) + __uint_as_float(rr[1]); }
    l_reg = l_reg * alpha + ps;
#define ATT_PK4(P, BASE, OUT) do { unsigned a0 = cvtpk(P[BASE + 0], P[BASE + 1]), a1 = cvtpk(P[BASE + 2], P[BASE + 3]);   \
    unsigned b0 = cvtpk(P[BASE + 4], P[BASE + 5]), b1 = cvtpk(P[BASE + 6], P[BASE + 7]);                              \
    auto r0 = __builtin_amdgcn_permlane32_swap(a0, b0, false, false); auto r1 = __builtin_amdgcn_permlane32_swap(a1, b1, false, false); \
    u32x4 w = {r0[0], r1[0], r0[1], r1[1]}; OUT = *reinterpret_cast<bf16x8*>(&w); } while (0)
    ATT_PK4(p0, 0, pa0); ATT_PK4(p0, 8, pa1); ATT_PK4(p1, 0, pa2); ATT_PK4(p1, 8, pa3);
#undef ATT_PK4
}
__device__ __forceinline__ int v_st(int k, int c) { const int kk = (k & ~0xC) | ((k & 4) << 1) | ((k & 8) >> 1); return ((kk >> 3) * 4 + (c >> 5)) * 512 + ((kk & 7) * 32 + (c & 31)) * 2; }
__device__ __forceinline__ int v_rd_base(int lane) { return ((lane & 3) << 3) | (((lane >> 2) & 3) << 6) | (((lane >> 4) & 1) << 5) | (((lane >> 5) & 1) << 8); }
constexpr int v_rd_off(int d0, int ks, int half) { return d0 * 512 + ks * 4096 + half * 2048; }
template <int OFF> __device__ __forceinline__ s16x4 tr_read(int vb) {
    s16x4 r; asm volatile("ds_read_b64_tr_b16 %0, %1 offset:%2" : "=&v"(r) : "v"(vb), "i"(OFF) : "memory"); return r;
}
template <int D0> __device__ __forceinline__ void pv_one(f32x16& od, int vb, bf16x8 pa0, bf16x8 pa1, bf16x8 pa2, bf16x8 pa3) {
    const s16x4 l0 = tr_read<v_rd_off(D0, 0, 0)>(vb), h0 = tr_read<v_rd_off(D0, 0, 1)>(vb), l1 = tr_read<v_rd_off(D0, 1, 0)>(vb), h1 = tr_read<v_rd_off(D0, 1, 1)>(vb);
    const s16x4 l2 = tr_read<v_rd_off(D0, 2, 0)>(vb), h2 = tr_read<v_rd_off(D0, 2, 1)>(vb), l3 = tr_read<v_rd_off(D0, 3, 0)>(vb), h3 = tr_read<v_rd_off(D0, 3, 1)>(vb);
    asm volatile("s_waitcnt lgkmcnt(0)" ::: "memory"); ASBAR();
#define ATT_PK(L, H) (bf16x8){L[0], L[1], L[2], L[3], H[0], H[1], H[2], H[3]}
    od = __builtin_amdgcn_mfma_f32_32x32x16_bf16(pa0, ATT_PK(l0, h0), od, 0, 0, 0);
    od = __builtin_amdgcn_mfma_f32_32x32x16_bf16(pa1, ATT_PK(l1, h1), od, 0, 0, 0);
    od = __builtin_amdgcn_mfma_f32_32x32x16_bf16(pa2, ATT_PK(l2, h2), od, 0, 0, 0);
    od = __builtin_amdgcn_mfma_f32_32x32x16_bf16(pa3, ATT_PK(l3, h3), od, 0, 0, 0);
#undef ATT_PK
}
__device__ __forceinline__ void pv_d0(f32x16* o, int vb, bf16x8 pa0, bf16x8 pa1, bf16x8 pa2, bf16x8 pa3) {
    pv_one<0>(o[0], vb, pa0, pa1, pa2, pa3); pv_one<1>(o[1], vb, pa0, pa1, pa2, pa3); pv_one<2>(o[2], vb, pa0, pa1, pa2, pa3); pv_one<3>(o[3], vb, pa0, pa1, pa2, pa3);
}

template <int DQK, bool DSA> __device__ __forceinline__ void qkt_init(f32x16& p0, f32x16& p1, const char* Ks, const bf16x8* qr, int r32, int hi, float cin, unsigned mlo, unsigned mhi) {
#pragma unroll
    for (int r = 0; r < 16; ++r) {
        if constexpr (DSA) { const int bit = (r & 3) + 8 * (r >> 2);
            const unsigned m0 = (unsigned)__builtin_amdgcn_sbfe((int)mlo, bit, 1), m1 = (unsigned)__builtin_amdgcn_sbfe((int)mhi, bit, 1);
            p0[r] = __uint_as_float((__float_as_uint(cin) & m0) | (0xff800000u & ~m0)); p1[r] = __uint_as_float((__float_as_uint(cin) & m1) | (0xff800000u & ~m1)); }
        else { p0[r] = cin; p1[r] = cin; }
    }
    bf16x8 zq; { int zz = 0; asm volatile("" : "+v"(zz)); zq = (bf16x8){(short)zz, (short)zz, (short)zz, (short)zz, (short)zz, (short)zz, (short)zz, (short)zz}; } (void)zq;
#pragma unroll
    for (int d0 = 0; d0 < DQK / 16; ++d0) { const int cb = (d0 * 16 + hi * 8) * 2;
        const bf16x8 b0 = *reinterpret_cast<const bf16x8*>(Ks + kswz<DQK>(r32, cb));
        const bf16x8 b1 = *reinterpret_cast<const bf16x8*>(Ks + kswz<DQK>(32 + r32, cb));
        p0 = __builtin_amdgcn_mfma_f32_32x32x16_bf16(b0, qr[d0], p0, 0, 0, 0);
        p1 = __builtin_amdgcn_mfma_f32_32x32x16_bf16(b1, qr[d0], p1, 0, 0, 0);
        if constexpr (PROBE_DUP == 43) {
            p0 = __builtin_amdgcn_mfma_f32_32x32x16_bf16(b0, zq, p0, 0, 0, 0); p1 = __builtin_amdgcn_mfma_f32_32x32x16_bf16(b1, zq, p1, 0, 0, 0); } }
    if constexpr (PROBE_DUP != 43) {
        constexpr int KPF = DSA ? KPF_DSA : KPF_DIFF, N = DQK / 16;
        if constexpr (KPF > 0) {
            __builtin_amdgcn_sched_group_barrier(0x100, 2 * KPF, 0);
#pragma unroll
            for (int d0 = 0; d0 < N - KPF; ++d0) { __builtin_amdgcn_sched_group_barrier(0x100, 2, 0); __builtin_amdgcn_sched_group_barrier(0x008, 2, 0); }
            __builtin_amdgcn_sched_group_barrier(0x008, 2 * KPF, 0);
        }
    }
}
__device__ __forceinline__ void bias_exp(f32x16& p0, f32x16& p1, float sl, bool band, float qrel) {
#pragma unroll
    for (int r = 0; r < 16; ++r) { const int bit = (r & 3) + 8 * (r >> 2);
        p0[r] = __builtin_fmaf(sl, (float)bit, p0[r]); p1[r] = __builtin_fmaf(sl, (float)(bit + 32), p1[r]); }
    if constexpr (PROBE_DUP == 44) {
        float z = 0.f; asm volatile("" : "+v"(z));
#pragma unroll
        for (int r = 0; r < 16; ++r) { const int bit = (r & 3) + 8 * (r >> 2);
            p0[r] = __builtin_fmaf(z, (float)bit, p0[r]); p1[r] = __builtin_fmaf(z, (float)(bit + 32), p1[r]); } }
    if (band) { const float sl2 = 2.f * sl;
#pragma unroll
        for (int r = 0; r < 16; ++r) { const int bit = (r & 3) + 8 * (r >> 2);
            const float d0 = qrel - (float)bit, d1 = d0 - 32.f;
            p0[r] = __builtin_fmaf(sl2, fminf(d0, 0.f), p0[r]); p1[r] = __builtin_fmaf(sl2, fminf(d1, 0.f), p1[r]); } }
#pragma unroll
    for (int r = 0; r < 16; ++r) p0[r] = __builtin_amdgcn_exp2f(p0[r]);
}

template <int DQK, bool DSA>
__device__ __forceinline__ void attn_body(const bf16* __restrict__ Qb, const bf16* __restrict__ Kh, const bf16* __restrict__ Vh, int NT, int tmaxw, int qpos0, int kshift, float nslope, float kmax2, const unsigned* __restrict__ nsd,
                                          const unsigned long long* __restrict__ mask, f32x16 (&o)[4], float (&rli)[16], char* lds) {
    int tid_ = threadIdx.x; asm volatile("" : "+v"(tid_));
    constexpr int SDEPTH = DSA ? SDEPTH_DSA : SDEPTH_DIFF;
    const int tid = tid_, wid = __builtin_amdgcn_readfirstlane(tid >> 6), lane = tid & 63, r32 = lane & 31, hi = lane >> 5;
    char* V_lds = lds + L_V; char* K_lds = lds + L_K;
    float* ws = (float*)(lds + L_WS) + wid * 64; float* li_l = ws;
    float l_reg = 0.f;
#pragma unroll
    for (int d = 0; d < 4; ++d) o[d] = f32x16{};
    bf16x8 qr[DQK / 16];
    const bf16* Qw = Qb + (size_t)(wid * QBLK + r32) * D + hi * 8;
#pragma unroll
    for (int d0 = 0; d0 < DQK / 16; ++d0) qr[d0] = *reinterpret_cast<const bf16x8*>(Qw + d0 * 16);
    const int qpos = qpos0 + wid * QBLK + r32;
    const float qrel0 = (float)(qpos - 4 * hi - kshift);
    const int vsr = tid >> 4, vsc = (tid & 15) * 8, vst0 = v_st(vsr, vsc), vst1 = v_st(32 + vsr, vsc);
    const int ksr = (DQK == 128) ? (tid >> 4) : (tid >> 3), ksc = (DQK == 128) ? (tid & 15) * 8 : (tid & 7) * 8;
    const int kst0 = kswz<DQK>(ksr, ksc * 2), kst1 = kswz<DQK>(32 + ksr, ksc * 2);
    const int vb0 = (int)(uintptr_t)V_lds + v_rd_base(lane);
    struct { bf16x8 vs0, vs1, ks0, ks1; unsigned long long mk; } sr_[SDEPTH];
    unsigned long long mkb0 = 0ull, mkb1 = 0ull;
    const unsigned long long* mrow = DSA ? (mask + (qpos0 + wid * QBLK + r32)) : nullptr;
#define ATT_SLOAD(i, t) do { const int k0_ = (t) * KVBLK; \
    sr_[i].vs0 = *reinterpret_cast<const bf16x8*>(&Vh[(size_t)(k0_ + vsr) * D + vsc]); sr_[i].vs1 = *reinterpret_cast<const bf16x8*>(&Vh[(size_t)(k0_ + 32 + vsr) * D + vsc]); \
    sr_[i].ks0 = *reinterpret_cast<const bf16x8*>(&Kh[(size_t)(k0_ + ksr) * D + ksc]); \
    if constexpr (DQK == 128) sr_[i].ks1 = *reinterpret_cast<const bf16x8*>(&Kh[(size_t)(k0_ + 32 + ksr) * D + ksc]); \
    if constexpr (DSA) sr_[i].mk = mrow[(size_t)(t) * S]; } while (0)
#define ATT_SWRITE(b, i) do { *(bf16x8*)(V_lds + (b) * SHM_V + vst0) = sr_[i].vs0; *(bf16x8*)(V_lds + (b) * SHM_V + vst1) = sr_[i].vs1; \
    *(bf16x8*)(K_lds + (b) * SHM_K + kst0) = sr_[i].ks0; \
    if constexpr (DQK == 128) *(bf16x8*)(K_lds + (b) * SHM_K + kst1) = sr_[i].ks1; \
    if constexpr (DSA) { if ((b) == 0) mkb0 = sr_[i].mk; else mkb1 = sr_[i].mk; } } while (0)
#define ATT_SWAIT() do { if constexpr (SDEPTH == 1) asm volatile("s_waitcnt vmcnt(0)" ::: "memory"); else if constexpr (DSA) asm volatile("s_waitcnt vmcnt(5)" ::: "memory"); else if constexpr (DQK == 128) asm volatile("s_waitcnt vmcnt(4)" ::: "memory"); else asm volatile("s_waitcnt vmcnt(3)" ::: "memory"); } while (0)
    const float sl = -nslope, sl64 = sl * 64.f, chi = sl * (float)(4 * hi);
    const int jband = NT - 5;
    float m0;
    { float qn = 0.f;
#pragma unroll
      for (int d0 = 0; d0 < DQK / 16; ++d0)
#pragma unroll
          for (int e = 0; e < 4; ++e) { const unsigned w = ((const unsigned*)&qr[d0])[e]; const float a = bflo(w), b = bfhi(w); qn += a * a + b * b; }
      { auto rr = __builtin_amdgcn_permlane32_swap(__float_as_uint(qn), __float_as_uint(qn), false, false); qn = __uint_as_float(rr[0]) + __uint_as_float(rr[1]); }
      int dn = 0; if constexpr (DSA) dn = (int)nsd[qpos];
      m0 = sl * (float)(qpos - kshift - dn) + (sqrtf(qn * kmax2) * 1.002f + 0.05f) - chi; }
#define ATT_QK(P0, P1, KB, t, MK) do { const bool vis_ = (t) <= tmaxw; float cin_ = sl64 * (float)(t) - m0; unsigned mlo_ = 0u, mhi_ = 0u; \
    if constexpr (DSA) { const unsigned long long mk_ = vis_ ? (MK) : 0ull; mlo_ = (unsigned)(mk_ & 0xffffffffull) >> (4 * hi); mhi_ = (unsigned)(mk_ >> 32) >> (4 * hi); } \
    else { cin_ = vis_ ? cin_ : -__builtin_inff(); } \
    qkt_init<DQK, DSA>(P0, P1, (KB), qr, r32, hi, cin_, mlo_, mhi_); } while (0)
#define ATT_BX(P0, P1, t) do { float qrel_ = qrel0 - (float)((t) * KVBLK); float sl_ = sl; asm volatile("" : "+v"(qrel_), "+v"(sl_)); bias_exp(P0, P1, sl_, (t) >= jband, qrel_); } while (0)
    f32x16 pA0, pA1, pB0, pB1; bf16x8 pa0, pa1, pa2, pa3;
    constexpr int SE = 0, SO = SDEPTH - 1;
    __syncthreads();
    ATT_SLOAD(SE, 0); asm volatile("s_waitcnt vmcnt(0)" ::: "memory"); ATT_SWRITE(0, SE); __syncthreads();
    ATT_QK(pA0, pA1, K_lds, 0, mkb0); ATT_BX(pA0, pA1, 0);
    ATT_SLOAD(SO, 1); if constexpr (SDEPTH == 2) { ATT_SLOAD(SE, 2); }
    ATT_SWAIT(); ATT_SWRITE(1, SO); __syncthreads();
    if (wid >= 4) __builtin_amdgcn_s_setprio(1);
    for (int j = 1; j + 1 < NT; j += 2) {
        if constexpr (SDEPTH == 1) { ATT_SLOAD(SO, j + SDEPTH); ASBAR(); }
        ASBAR(); ATT_QK(pB0, pB1, K_lds + SHM_K, j, mkb1);
        finishSM(pA0, pA1, 1.f, l_reg, pa0, pa1, pa2, pa3); ASBAR();
        if constexpr (SDEPTH != 1) { ATT_SLOAD(SO, j + SDEPTH); ASBAR(); }
        pv_d0(o, vb0, pa0, pa1, pa2, pa3); ATT_BX(pB0, pB1, j);
        __syncthreads(); ATT_SWAIT(); ATT_SWRITE(0, SE);
        __syncthreads();
        if constexpr (SDEPTH == 1) { ATT_SLOAD(SE, j + 1 + SDEPTH); ASBAR(); }
        ASBAR(); ATT_QK(pA0, pA1, K_lds, j + 1, mkb0);
        finishSM(pB0, pB1, 1.f, l_reg, pa0, pa1, pa2, pa3); ASBAR();
        if constexpr (SDEPTH != 1) { ATT_SLOAD(SE, (j + 3 < NT) ? j + 3 : NT - 1); ASBAR(); }
        pv_d0(o, vb0 + SHM_V, pa0, pa1, pa2, pa3); ATT_BX(pA0, pA1, j + 1);
        __syncthreads(); ATT_SWAIT(); ATT_SWRITE(1, SO);
        __syncthreads();
    }
    __builtin_amdgcn_s_setprio(0);
    ASBAR(); ATT_QK(pB0, pB1, K_lds + SHM_K, NT - 1, mkb1);
    finishSM(pA0, pA1, 1.f, l_reg, pa0, pa1, pa2, pa3); ASBAR();
    pv_d0(o, vb0, pa0, pa1, pa2, pa3); ATT_BX(pB0, pB1, NT - 1);
    __syncthreads();
    finishSM(pB0, pB1, 1.f, l_reg, pa0, pa1, pa2, pa3); ASBAR();
    pv_d0(o, vb0 + SHM_V, pa0, pa1, pa2, pa3);
    if (hi == 0) li_l[r32] = l_reg; asm volatile("s_waitcnt lgkmcnt(0)" ::: "memory");
#pragma unroll
    for (int r = 0; r < 16; ++r) rli[r] = __builtin_amdgcn_rcpf(li_l[crow(r, hi)]);
#undef ATT_SLOAD
#undef ATT_SWRITE
#undef ATT_SWAIT
#undef ATT_QK
#undef ATT_BX
}
}

__device__ __forceinline__ float alibi_slope(int h) { return __builtin_amdgcn_exp2f(-(float)(h + 1)); }

template <int DQK> __device__ __forceinline__ float unit_qmax(Frame& F, const bf16* Qb) {
    LAS unsigned* qm = (LAS unsigned*)(F.lds + L_TINFO);
    const int lane = F.lane, wid = F.wave, r32 = lane & 31, hi = lane >> 5;
    __syncthreads();
    if (F.tid == 0) qm[0] = 0u;
    __syncthreads();
    const bf16* Qw = Qb + (size_t)(wid * 32 + r32) * D + hi * 8;
    float qn = 0.f;
#pragma unroll
    for (int d0 = 0; d0 < DQK / 16; ++d0) { const v4u w4 = *(const v4u*)(Qw + d0 * 16);
#pragma unroll
        for (int e = 0; e < 4; ++e) { const float a = bflo(w4[e]), b = bfhi(w4[e]); qn += a * a + b * b; } }
    qn += __shfl_xor(qn, 32);
#pragma unroll
    for (int o = 1; o < 32; o <<= 1) qn = fmaxf(qn, __shfl_xor(qn, o));
    if (lane == 0) __hip_atomic_fetch_max(&qm[0], __float_as_uint(qn), __ATOMIC_RELAXED, __HIP_MEMORY_SCOPE_WORKGROUP);
    __syncthreads();
    return __uint_as_float(qm[0]);
}
__device__ __forceinline__ int unit_first_tile(int h, int qb, float qmax2, float kmax2, float dsel) {
    const float sl = alibi_slope(h) * LOG2E, b2 = sqrtf(qmax2 * kmax2);
    const float w = (152.f + 2.f * 1.002f * b2 + 1.f) / sl + dsel;
    const float t = floorf(((float)(256 * qb) - w) * (1.f / 64.f)) - 1.f;
    int t0 = (t > 0.f) ? (int)t : 0; if (t0 > 4 * qb) t0 = 4 * qb;
    return t0 & ~1;
}
__device__ __forceinline__ void diff_unit(Frame& F, char* lds, int h, int qb, int c, int qword) {
    using namespace att;
    const int lane = F.lane, wid = F.wave, r32 = lane & 31, hi = lane >> 5;
    const bf16* QA = (const bf16*)(F.ws + WS_PROJ) + 0 * PROJ_STRIDE;
    const bf16* KA = (const bf16*)(F.ws + WS_PROJ) + 1 * PROJ_STRIDE;
    const bf16* VA = (const bf16*)(F.ws + WS_PROJ) + 2 * PROJ_STRIDE;
    bf16* OC = (bf16*)(F.ws + WS_SCR) + (size_t)c * PROJ_STRIDE;
    const int q0 = qb * 256;
    const float kmax2 = __uint_as_float(__hip_atomic_load(F.ctl + CW_NRM + 16 + h * 2 + c, RLX_AGENT));
    const int T0 = unit_first_tile(h, qb, unit_qmax<64>(F, QA + (size_t)q0 * D + h * 128 + c * 64), kmax2, 0.f);
    const int NT = 4 * qb + 4 - T0, tmaxw = 4 * qb + (wid >> 1) - T0;
    const float nslope = -alibi_slope(h) * LOG2E;
    const size_t koff = (size_t)T0 * 64 * D;
    f32x16 o[4]; float rli[16];
    attn_body<64, false>(QA + (size_t)q0 * D + h * 128 + c * 64, KA + koff + h * 128 + c * 64, VA + koff + h * 128, NT, tmaxw, q0, 64 * T0, nslope, kmax2, nullptr, nullptr, o, rli, lds);
    int qn_ = 0; if (F.tid == 0) qn_ = (int)__hip_atomic_fetch_add(F.ctl + qword, 1u, RLX_AGENT);
    bf16* Ow = OC + (size_t)(q0 + wid * QBLK + 4 * hi) * D + h * 128 + r32; asm volatile("" : "+v"(Ow));
#pragma unroll
    for (int r = 0; r < 16; ++r) { bf16* op = Ow + (size_t)((r & 3) + 8 * (r >> 2)) * D; if ((r & 3) == 0) asm volatile("" : "+v"(op));
#pragma unroll
        for (int d0 = 0; d0 < 4; ++d0) op[d0 * 32] = (bf16)f2bf(o[d0][r] * rli[r]); }
    if (F.tid == 0) *(LAS int*)(F.lds + L_QI) = qn_;
}
__device__ __forceinline__ void p4c_combine(Frame& F, float lam) {
    const bf16* O0 = (const bf16*)(F.ws + WS_SCR); const bf16* O1 = O0 + PROJ_STRIDE; unsigned char* YA = (unsigned char*)(F.ws + WS_YA);
    const int lane = F.lane, gw = F.bid * NWAVES + F.wave, NGW = F.G * NWAVES;
    f32x4 g[4];
#pragma unroll
    for (int j = 0; j < 4; ++j) g[j] = *((const f32x4*)(FIN(F, 9) + (lane & 7) * 16) + j) * (1.f - LAM_INIT);
    for (int rp_ = 0; rp_ < ((PROBE_DUP == 50) ? 2 : 1); ++rp_)
#pragma unroll 2
    for (int m = gw; m < S; m += NGW) {
        const v4u* a = (const v4u*)(O0 + (size_t)m * D) + 2 * lane; const v4u* b = (const v4u*)(O1 + (size_t)m * D) + 2 * lane;
        const v4u a0 = a[0], a1 = a[1], b0 = b[0], b1 = b[1];
        f32x4 y[4]; float s = 0.f;
#pragma unroll
        for (int j = 0; j < 4; ++j) { const unsigned aw0 = (j < 2) ? a0[2 * j] : a1[2 * j - 4], aw1 = (j < 2) ? a0[2 * j + 1] : a1[2 * j - 3];
            const unsigned bw0 = (j < 2) ? b0[2 * j] : b1[2 * j - 4], bw1 = (j < 2) ? b0[2 * j + 1] : b1[2 * j - 3];
            y[j].x = bflo(aw0) - lam * bflo(bw0); y[j].y = bfhi(aw0) - lam * bfhi(bw0); y[j].z = bflo(aw1) - lam * bflo(bw1); y[j].w = bfhi(aw1) - lam * bfhi(bw1);
            s += (y[j].x * y[j].x + y[j].y * y[j].y) + (y[j].z * y[j].z + y[j].w * y[j].w); }
        s += __shfl_xor(s, 1); s += __shfl_xor(s, 2); s += __shfl_xor(s, 4);
        const float rinv = 1.0f / sqrtf(s * (1.f / 128.f) + LN_EPS);
        v4u w0;
        { const float rs = rinv * Y_FP8_SCALE; const f32x4 t0 = y[0] * rs * g[0], t1 = y[1] * rs * g[1], t2 = y[2] * rs * g[2], t3 = y[3] * rs * g[3];
          w0.x = pk4_fp8(t0.x, t0.y, t0.z, t0.w); w0.y = pk4_fp8(t1.x, t1.y, t1.z, t1.w); w0.z = pk4_fp8(t2.x, t2.y, t2.z, t2.w); w0.w = pk4_fp8(t3.x, t3.y, t3.z, t3.w); }
        *((v4u*)(YA + (size_t)m * D) + lane) = w0;
    }
}

__device__ __forceinline__ void dsa_unit(Frame& F, char* lds, int h, int qb, int qword) {
    using namespace att;
    const int lane = F.lane, wid = F.wave, r32 = lane & 31, hi = lane >> 5;
    const bf16* QB = (const bf16*)(F.ws + WS_PROJ) + 3 * PROJ_STRIDE;
    const bf16* KB = (const bf16*)(F.ws + WS_PROJ) + 4 * PROJ_STRIDE;
    const bf16* VB = (const bf16*)(F.ws + WS_PROJ) + 5 * PROJ_STRIDE;
    unsigned char* YB = (unsigned char*)(F.ws + WS_YB);
    const int q0 = qb * 256;
    const float kmax2 = __uint_as_float(__hip_atomic_load(F.ctl + CW_NRM + 40 + h, RLX_AGENT));
    const int T0 = unit_first_tile(h, qb, unit_qmax<128>(F, QB + (size_t)q0 * D + h * 128), kmax2, (float)__hip_atomic_load(F.ctl + CW_NRM + 64 + qb, RLX_AGENT));
    const int NT = 4 * qb + 4 - T0, tmaxw = 4 * qb + (wid >> 1) - T0;
    const float nslope = -alibi_slope(h) * LOG2E;
    const size_t koff = (size_t)T0 * 64 * D;
    f32x16 o[4]; float rli[16];
    attn_body<128, true>(QB + (size_t)q0 * D + h * 128, KB + koff + h * 128, VB + koff + h * 128, NT, tmaxw, q0, 64 * T0, nslope, kmax2, (const unsigned*)(F.ws + WS_NSD), (const unsigned long long*)(F.ws + WS_MASK) + (size_t)T0 * S, o, rli, lds);
    int qn_ = 0; if (F.tid == 0) qn_ = (int)__hip_atomic_fetch_add(F.ctl + qword, 1u, RLX_AGENT);
    unsigned char* Yw = YB + (size_t)(q0 + wid * QBLK + 4 * hi) * D + h * 128 + r32; asm volatile("" : "+v"(Yw));
#pragma unroll
    for (int r = 0; r < 16; ++r) { unsigned char* yp = Yw + (size_t)((r & 3) + 8 * (r >> 2)) * D; if ((r & 3) == 0) asm volatile("" : "+v"(yp)); const float rs = rli[r] * Y_FP8_SCALE;
#pragma unroll
        for (int d0 = 0; d0 < 4; ++d0) { const float v = o[d0][r] * rs; yp[d0 * 32] = (unsigned char)__builtin_amdgcn_cvt_pk_fp8_f32(v, v, 0, false); } }
    if (F.tid == 0) *(LAS int*)(F.lds + L_QI) = qn_;
}

__device__ __forceinline__ int queue_next(Frame& F, int word);
__device__ __forceinline__ void p3_norms(Frame& F) {
    const bf16* P = (const bf16*)(F.ws + WS_PROJ);
    const int lane = F.lane, gw = F.bid * NWAVES + F.wave, NGW = F.G * NWAVES;
    float mx[4] = {0.f, 0.f, 0.f, 0.f};
#ifndef PROBE_DUP
#define PROBE_DUP -1
#endif
    (void)gw; (void)NGW;
    for (;;) { const int ch = queue_next(F, CW_Q3 + 32); if (ch >= S / 32) break;
#pragma unroll
    for (int rr_ = 0; rr_ < 4; ++rr_) { const int m = ch * 32 + F.wave * 4 + rr_;
#pragma unroll
        for (int a = 1; a < 4; a += 2) {
            const int buf = (a == 0) ? 0 : (a == 1) ? 1 : (a == 2) ? 3 : 4;
            const v4u* r = (const v4u*)(P + (size_t)buf * PROJ_STRIDE + (size_t)m * D) + 2 * lane;
            const v4u w0 = r[0], w1 = r[1]; float s = 0.f;
#pragma unroll
            for (int e = 0; e < 4; ++e) { const float x0 = bflo(w0[e]), x1 = bfhi(w0[e]), x2 = bflo(w1[e]), x3 = bfhi(w1[e]); s += (x0 * x0 + x1 * x1) + (x2 * x2 + x3 * x3); }
            s += __shfl_xor(s, 1); s += __shfl_xor(s, 2);
            if (a >= 2) s += __shfl_xor(s, 4);
            mx[a] = fmaxf(mx[a], s);
        }
    } }
    if ((lane & 3) == 0) __hip_atomic_fetch_max(F.ctl + CW_NRM + 16 + (lane >> 2), __float_as_uint(mx[1]), RLX_AGENT);
    if ((lane & 7) == 0) __hip_atomic_fetch_max(F.ctl + CW_NRM + 40 + (lane >> 3), __float_as_uint(mx[3]), RLX_AGENT);
}
__device__ __forceinline__ void build_order(Frame& F, int kind) {
    LAS unsigned* key = (LAS unsigned*)(F.lds + L_ORDER); LAS unsigned short* t0tab = (LAS unsigned short*)(F.lds + L_T0);
    __syncthreads();
#pragma unroll
    for (int half = 0; half < 2; ++half) { int u = F.tid + 512 * half; asm volatile("" : "+v"(u)); const int h = (u >> 6) & 7, qb = u & 63;
        if (kind == 0) { const int hc = 15 - (u & 15), q = 63 - (u >> 4); key[u] = (unsigned)((hc & 1) * 512 + (hc >> 1) * 64 + q); }
        else if (half == 0) { key[u] = (unsigned)((7 - (u & 7)) * 64 + (63 - (u >> 3))); }
        (void)h; (void)qb; (void)t0tab; }
    __syncthreads();
}

namespace idx {
using bf16x8 = __attribute__((ext_vector_type(8))) short;
typedef float f4 __attribute__((ext_vector_type(4)));
constexpr int IQ_OFF = 0, CS_OFF = 34816, CI_OFF = 108544;
constexpr int CAP = 1152, NPL = CAP / 64, TRIG = CAP - 512;
__device__ __forceinline__ unsigned ord(float f) { const unsigned b = __float_as_uint(f); return (b & 0x80000000u) ? ~b : (b | 0x80000000u); }
__device__ __forceinline__ float unord(unsigned u) { return __uint_as_float((u & 0x80000000u) ? (u & 0x7fffffffu) : ~u); }

__device__ __forceinline__ int wave_total(int v) {
    v += __builtin_amdgcn_update_dpp(0, v, 0x111, 0xf, 0xf, true); v += __builtin_amdgcn_update_dpp(0, v, 0x112, 0xf, 0xf, true);
    v += __builtin_amdgcn_update_dpp(0, v, 0x114, 0xf, 0xf, true); v += __builtin_amdgcn_update_dpp(0, v, 0x118, 0xf, 0xf, true);
    v += __builtin_amdgcn_update_dpp(0, v, 0x142, 0xa, 0xf, false);
    v += __builtin_amdgcn_update_dpp(0, v, 0x143, 0xc, 0xf, false);
    return __builtin_amdgcn_readlane(v, 63);
}
__device__ __forceinline__ unsigned wave_umax(unsigned v) {
    v = max(v, (unsigned)__builtin_amdgcn_update_dpp(0, (int)v, 0x111, 0xf, 0xf, true)); v = max(v, (unsigned)__builtin_amdgcn_update_dpp(0, (int)v, 0x112, 0xf, 0xf, true));
    v = max(v, (unsigned)__builtin_amdgcn_update_dpp(0, (int)v, 0x114, 0xf, 0xf, true)); v = max(v, (unsigned)__builtin_amdgcn_update_dpp(0, (int)v, 0x118, 0xf, 0xf, true));
    v = max(v, (unsigned)__builtin_amdgcn_update_dpp(0, (int)v, 0x142, 0xa, 0xf, false));
    v = max(v, (unsigned)__builtin_amdgcn_update_dpp(0, (int)v, 0x143, 0xc, 0xf, false));
    return (unsigned)__builtin_amdgcn_readlane((int)v, 63);
}
__device__ __forceinline__ void prune_row(LAS unsigned char* lds, int row, int n, int lane, bool exact) {
    LAS float* cs = (LAS float*)(lds + CS_OFF) + row * CAP;
    LAS unsigned short* ci = (LAS unsigned short*)(lds + CI_OFF) + row * CAP;
    unsigned u[NPL]; unsigned id[NPL];
    { float f_[NPL];
#pragma unroll
      for (int i = 0; i < NPL; ++i) { const int e = lane + 64 * i; f_[i] = cs[e]; id[i] = ci[e]; }
      __builtin_amdgcn_sched_barrier(0);
#pragma unroll
      for (int i = 0; i < NPL; ++i) { const bool v = (lane + 64 * i) < n; u[i] = v ? ord(f_[i]) : 0u; id[i] = v ? id[i] : 0xffffu; } }
    unsigned umx = 0u;
#pragma unroll
    for (int i = 0; i < NPL; ++i) umx = max(umx, u[i]);
    umx = wave_umax(umx);
    const unsigned ulo = ord(((LAS float*)(lds + L_BASE))[row]);
    const unsigned dif = ulo ^ umx;
    const int topbit = dif ? (31 - __builtin_clz(dif)) : -1;
    const unsigned T0 = (topbit >= 31) ? 0u : ((topbit < 0) ? ulo : (ulo & ~((2u << topbit) - 1u)));
    unsigned T = T0;
    int cT = n;
#ifndef PROBE_DUP
#define PROBE_DUP -1
#endif
#pragma unroll 1
    for (int rp_ = 0; rp_ < ((PROBE_DUP == 33) ? 2 : 1); ++rp_) { T = T0; cT = n; asm volatile("" : "+s"(T));
    for (int bit = topbit; bit >= 0; --bit) {
        if (!exact && cT <= 320) break;
        const unsigned cand = T | (1u << bit); int c = 0;
#pragma unroll
        for (int i = 0; i < NPL; ++i) c += (u[i] >= cand) ? 1 : 0;
        c = wave_total(c);
        if (c >= 256) { T = cand; cT = c; }
    } }
    int cgt = 0, ceq = 0;
#pragma unroll
    for (int i = 0; i < NPL; ++i) { cgt += (u[i] > T) ? 1 : 0; ceq += (u[i] == T) ? 1 : 0; }
    cgt = wave_total(cgt); ceq = wave_total(ceq);
    const int need = 256 - cgt;
    unsigned I = 0xffffu;
    if (exact && ceq > need) {
        I = 0u;
        for (int bit = 13; bit >= 0; --bit) {
            const unsigned cand = I | (1u << bit); int c = 0;
#pragma unroll
            for (int i = 0; i < NPL; ++i) c += (u[i] == T && id[i] < cand) ? 1 : 0;
            c = wave_total(c);
            if (c < need) I = cand;
        }
    }
    int base = 0;
#pragma unroll
    for (int i = 0; i < NPL; ++i) {
        const bool k = exact ? ((u[i] > T) || (u[i] == T && id[i] <= I)) : (u[i] >= T);
        const unsigned long long b = __ballot(k);
        const int pos = base + (int)__builtin_amdgcn_mbcnt_hi((unsigned)(b >> 32), __builtin_amdgcn_mbcnt_lo((unsigned)b, 0u));
        if (k) { cs[pos] = unord(u[i]); ci[pos] = (unsigned short)id[i]; }
        base += __builtin_popcountll(b);
    }
    if (lane == 0) { ((LAS unsigned*)(lds + L_CNT))[row] = (unsigned)base; ((LAS float*)(lds + L_BASE))[row] = unord(T); }
}

template <int TPR> __device__ __forceinline__ bool idx_rounds(LAS unsigned char* lds, const bf16* KI, int ntiles, int q, int kg, int wave, int lane, LAS unsigned* cnt, LAS float* thr, LAS float* wl) {
    LAS float* cs = (LAS float*)(lds + CS_OFF) + q * CAP;
    LAS unsigned short* ci = (LAS unsigned short*)(lds + CI_OFF) + q * CAP;
    const int nrounds = (ntiles + 8 * TPR - 1) / (8 * TPR);
    bf16x8 kf[4][2];
#define IDX_LOADK(jj) do { _Pragma("unroll") for (int st = 0; st < 4; ++st) _Pragma("unroll") for (int s_ = 0; s_ < 2; ++s_) \
        kf[st][s_] = *(const bf16x8*)(KI + (size_t)((jj) * 64 + st * 16 + q) * 64 + s_ * 32 + kg * 8); } while (0)
    if (wave < ntiles) IDX_LOADK(wave);
    for (int rd = 0; rd < nrounds; ++rd) {
#pragma unroll 1
        for (int tt = 0; tt < TPR; ++tt) {
        const int j = (rd * TPR + tt) * 8 + wave;
        if (j < ntiles) {
            f4 sc[4];
#ifndef PROBE_DUP
#define PROBE_DUP -1
#endif
#pragma unroll 1
            for (int rp_ = 0; rp_ < ((PROBE_DUP == 30) ? 2 : 1); ++rp_) {
#pragma unroll
            for (int st = 0; st < 4; ++st) sc[st] = (f4){0.f, 0.f, 0.f, 0.f};
#define IDX_MM(R, g_) do { const LAS unsigned char* qp_ = lds + IQ_OFF + (g_) * 2048 + lane * 16; \
                const bf16x8 qf0_ = *(const LAS bf16x8*)(qp_); const bf16x8 qf1_ = *(const LAS bf16x8*)(qp_ + 1024); \
                _Pragma("unroll") for (int st = 0; st < 4; ++st) R[st] = __builtin_amdgcn_mfma_f32_16x16x32_bf16(kf[st][0], qf0_, (f4){0.f, 0.f, 0.f, 0.f}, 0, 0, 0); \
                _Pragma("unroll") for (int st = 0; st < 4; ++st) R[st] = __builtin_amdgcn_mfma_f32_16x16x32_bf16(kf[st][1], qf1_, R[st], 0, 0, 0); } while (0)
#define IDX_FOLD(R, wv) do { _Pragma("unroll") for (int st = 0; st < 4; ++st) _Pragma("unroll") for (int e = 0; e < 4; ++e) \
                { float t_ = __builtin_fmaf(__builtin_fabsf(R[st][e]), (wv), sc[st][e]); asm("" : "+v"(t_)); sc[st][e] = t_; } } while (0)
#define IDX_FOLDP(R, wv) do { _Pragma("unroll") for (int st = 0; st < 4; ++st) _Pragma("unroll") for (int e = 0; e < 4; ++e) \
                sc[st][e] = __builtin_fmaf(R[st][e], (wv), sc[st][e]); } while (0)
            f4 ra[4], rb[4];
            IDX_MM(ra, 0);
#pragma unroll 1
            for (int g2 = 0; g2 < 8; ++g2) {
                const float w0 = 0.5f * wl[q * 16 + 2 * g2], w1 = 0.5f * wl[q * 16 + 2 * g2 + 1];
                IDX_MM(rb, 2 * g2 + 1);
                IDX_FOLD(ra, w0);
                IDX_MM(ra, 2 * g2 + 2);
                IDX_FOLD(rb, w1);
            }
            IDX_FOLDP(ra, 0.5f);
#undef IDX_MM
#undef IDX_FOLD
#undef IDX_FOLDP
            }
            if (j + 8 < ntiles) IDX_LOADK(j + 8);
            const float th = thr[q];
            int c = 0;
#pragma unroll
            for (int st = 0; st < 4; ++st)
#pragma unroll
                for (int e = 0; e < 4; ++e) c += (sc[st][e] > th) ? 1 : 0;
            unsigned pos = 0u;
            if (c) pos = __hip_atomic_fetch_add(&cnt[q], (unsigned)c, __ATOMIC_RELAXED, __HIP_MEMORY_SCOPE_WORKGROUP);
            asm volatile("" : "+v"(pos));
#pragma unroll
            for (int st = 0; st < 4; ++st)
#pragma unroll
                for (int e = 0; e < 4; ++e) {
                    const float v = sc[st][e];
                    if (v > th) { if (pos < (unsigned)CAP) { cs[pos] = v; ci[pos] = (unsigned short)(j * 64 + st * 16 + kg * 4 + e); } ++pos; }
                }
        } }
        __syncthreads();
        if constexpr (TPR > 1) { if (__any(lane < 16 && cnt[lane & 15] > (unsigned)((PROBE_DUP == 31) ? 900 : CAP))) return true; }
        const bool last = (rd == nrounds - 1);
        const bool anyover = __any(lane < 16 && cnt[lane & 15] > (unsigned)TRIG);
        if (last || anyover) {
#pragma unroll
            for (int rr = 0; rr < 2; ++rr) { const int row = wave + 8 * rr; int c = (int)cnt[row]; c = c > CAP ? CAP : c;
                if (last ? (c > 256) : (c > 320)) prune_row(lds, row, c, lane, last); }
        }
        __syncthreads();
    }
#undef IDX_LOADK
    return false;
}
__device__ __forceinline__ void index_unit(Frame& F, int ub) {
    LAS unsigned char* lds = F.lds;
    const int tid = F.tid, lane = F.lane, wave = F.wave;
    const int q0 = ub * 16, N = ((q0 >> 6) + 1) << 6, ntiles = N >> 6;
    unsigned long long* M = (unsigned long long*)(F.ws + WS_MASK);
    if (N <= 256) {
        for (int p = tid; p < ntiles * 16; p += 512) M[(size_t)(p >> 4) * S + q0 + (p & 15)] = ~0ull;
        if (tid < 16) ((unsigned*)(F.ws + WS_NSD))[q0 + tid] = 0u;
        return;
    }
    const bf16* QI = (const bf16*)(F.ws + WS_PROJ) + 6 * PROJ_STRIDE;
    const bf16* KI = (const bf16*)(F.ws + WS_KI);
    const float* WI = (const float*)(F.ws + WS_WI);
    LAS unsigned* cnt = (LAS unsigned*)(lds + L_CNT);
    LAS float* thr = (LAS float*)(lds + L_BASE);
    __syncthreads();
#pragma unroll
    for (int i = 0; i < 4; ++i) { const int p = tid + 512 * i, q = p >> 7, ch = p & 127, g = ch >> 3, s = (ch >> 2) & 1, kg = ch & 3;
        const v4u v = *(const v4u*)(QI + (size_t)(q0 + q) * D + ch * 8);
        *(LAS v4u*)(lds + IQ_OFF + ((g * 2 + s) * 4 + kg) * 256 + q * 16) = v; }
    if (tid < 16) { cnt[tid] = 0u; thr[tid] = -__builtin_inff(); }
    const int q = lane & 15, kg = lane >> 4;
    LAS float* wl = (LAS float*)(lds + L_TINFO);
    if (tid < 256) wl[tid] = WI[(size_t)q0 * 16 + tid];
    __syncthreads();
    { const int q_ = tid >> 5, dp = (tid & 31) * 2;
      const int s_ = dp >> 5, kg_ = (dp & 31) >> 3, o_ = ((s_ * 4 + kg_) * 256) + q_ * 16 + (dp & 7) * 2;
      float a0 = 0.f, a1 = 0.f;
#pragma unroll
      for (int g = 0; g < 16; ++g) { const unsigned w2 = *(const LAS unsigned*)(lds + IQ_OFF + g * 2048 + o_); const float wg = wl[q_ * 16 + g]; a0 = __builtin_fmaf(wg, bflo(w2), a0); a1 = __builtin_fmaf(wg, bfhi(w2), a1); }
      *(LAS unsigned*)(lds + IQ_OFF + 16 * 2048 + o_) = pk2(a0, a1); }
    __syncthreads();
    if (idx_rounds<2>(lds, KI, ntiles, q, kg, wave, lane, cnt, thr, wl)) {
        __syncthreads();
        if (tid < 16) { cnt[tid] = 0u; thr[tid] = -__builtin_inff(); }
        __syncthreads();
        idx_rounds<1>(lds, KI, ntiles, q, kg, wave, lane, cnt, thr, wl);
    }
    LAS unsigned* bm = (LAS unsigned*)(lds + IQ_OFF);
    for (int p = tid; p < 16 * 512; p += 512) bm[p] = 0u;
    __syncthreads();
    if (tid < 16) cnt[tid] = 0x7fffffffu;
    __syncthreads();
    for (int p = tid; p < 16 * 256; p += 512) { const int row = p >> 8, k = p & 255;
        const unsigned key = ((LAS unsigned short*)(lds + CI_OFF))[row * CAP + k];
        __hip_atomic_fetch_or(&bm[row * 512 + (key >> 5)], 1u << (key & 31), __ATOMIC_RELAXED, __HIP_MEMORY_SCOPE_WORKGROUP);
        const int dd = (q0 + row) - (int)key; __hip_atomic_fetch_min(&cnt[row], (unsigned)(dd < 0 ? -dd : dd), __ATOMIC_RELAXED, __HIP_MEMORY_SCOPE_WORKGROUP); }
    __syncthreads();
    if (tid < 16) { __hip_atomic_fetch_max(F.ctl + CW_NRM + 64 + (q0 >> 8), cnt[tid], RLX_AGENT); ((unsigned*)(F.ws + WS_NSD))[q0 + tid] = cnt[tid]; }
    for (int p = tid; p < ntiles * 16; p += 512) { const int t = p >> 4, row = p & 15;
        const unsigned lo = bm[row * 512 + 2 * t], hiw = bm[row * 512 + 2 * t + 1];
        M[(size_t)t * S + q0 + row] = ((unsigned long long)hiw << 32) | lo; }
}
}

__device__ __forceinline__ void p0_mod(Frame& F) {
    if (F.bid < 96) {
        const int col = F.bid * 64 + F.lane, k0 = F.wave * 128;
        float acc = 0.f;
#pragma unroll 8
        for (int k = 0; k < 128; ++k) { const float cv = FIN(F, 1)[k0 + k]; const float sl = cv / (1.f + __expf(-cv)); acc = __builtin_fmaf(sl, FIN(F, 2)[(size_t)(k0 + k) * 6144 + col], acc); }
        LAS float* red = (LAS float*)(F.lds + RING_OFF + 8 * 16384 - 4096);
        red[F.wave * 64 + F.lane] = acc;
        __syncthreads();
        if (F.wave == 0) { float s = 0.f;
#pragma unroll
            for (int w = 0; w < 8; ++w) s += red[w * 64 + F.lane];
            ((float*)(F.ws + WS_SMALL))[col] = s + FIN(F, 3)[col]; }
        __syncthreads();
    }
}
template <class Map>
__device__ __forceinline__ void transpose_item(const float* W, int K, int N, bf16* WT, LAS float* scr, int item, int lane, Map map) {
    const int nblk = (N + 31) / 32, kb = item / nblk, nb = item % nblk, k0 = 64 * kb, n0 = 32 * nb;
    const int ncol = n0 + (lane & 31); const bool ok = ncol < N;
#pragma unroll 8
    for (int i = 0; i < 32; ++i) { const int kk = 2 * i + (lane >> 5); scr[kk * 33 + (lane & 31)] = ok ? W[(size_t)(k0 + kk) * N + ncol] : 0.f; }
    LDS_WAIT(); asm volatile("" ::: "memory");
    const int c = lane & 7;
#pragma unroll
    for (int j = 0; j < 4; ++j) { const int n = (lane >> 3) + 8 * j; const LAS float* s = scr + (8 * c) * 33 + n;
        v4u o; o.x = pk2(s[0 * 33], s[1 * 33]); o.y = pk2(s[2 * 33], s[3 * 33]); o.z = pk2(s[4 * 33], s[5 * 33]); o.w = pk2(s[6 * 33], s[7 * 33]);
        if (n0 + n < N) *(GAS v4u*)(WT + (size_t)map(n0 + n) * K + k0 + 8 * c) = o; }
    LDS_WAIT(); asm volatile("" ::: "memory");
}
__device__ __forceinline__ void transpose_item_fp8(const float* W, int K, int N, unsigned char* WT, LAS float* scr, int item, int lane, float scale) {
    const int nblk = N / 32, kb = item / nblk, nb = item % nblk, k0 = 64 * kb, n0 = 32 * nb;
    { f32x4 v[8]; const int c4 = (lane & 7) * 4, kr = lane >> 3;
#pragma unroll
      for (int i = 0; i < 8; ++i) v[i] = *(const f32x4*)(W + (size_t)(k0 + 8 * i + kr) * N + n0 + c4);
#pragma unroll
      for (int i = 0; i < 8; ++i) { LAS float* d = scr + (8 * i + kr) * 33 + c4; d[0] = v[i].x; d[1] = v[i].y; d[2] = v[i].z; d[3] = v[i].w; } }
    LDS_WAIT(); asm volatile("" ::: "memory");
    const int n = lane >> 1, hf = lane & 1; const LAS float* s = scr + (32 * hf) * 33 + n;
    v4u o0, o1;
#pragma unroll
    for (int j = 0; j < 4; ++j) { o0[j] = pk4_fp8(s[(4 * j) * 33] * scale, s[(4 * j + 1) * 33] * scale, s[(4 * j + 2) * 33] * scale, s[(4 * j + 3) * 33] * scale);
        o1[j] = pk4_fp8(s[(16 + 4 * j) * 33] * scale, s[(17 + 4 * j) * 33] * scale, s[(18 + 4 * j) * 33] * scale, s[(19 + 4 * j) * 33] * scale); }
    GAS v4u* d = (GAS v4u*)(WT + (size_t)(n0 + n) * K + k0 + 32 * hf); d[0] = o0; d[1] = o1;
    LDS_WAIT(); asm volatile("" ::: "memory");
}
template <int NI> __device__ __forceinline__ void transpose_items_fp8(const float* W, int K, int N, unsigned char* WT, LAS float* scr, int item0, int lane, float scale) {
    const int nblk = N / 32, c4 = (lane & 7) * 4, kr = lane >> 3;
    f32x4 v[NI][8];
#pragma unroll
    for (int t = 0; t < NI; ++t) { const int item = item0 + t, kb = item / nblk, nb = item % nblk; const float* src = W + (size_t)(64 * kb + kr) * N + 32 * nb + c4;
#pragma unroll
        for (int i = 0; i < 8; ++i) v[t][i] = *(const f32x4*)(src + (size_t)(8 * i) * N); }
    __builtin_amdgcn_sched_barrier(0);
#pragma unroll
    for (int t = 0; t < NI; ++t) { const int item = item0 + t, kb = item / nblk, nb = item % nblk, k0 = 64 * kb, n0 = 32 * nb;
#pragma unroll
        for (int i = 0; i < 8; ++i) { LAS float* d = scr + (8 * i + kr) * 33 + c4; d[0] = v[t][i].x; d[1] = v[t][i].y; d[2] = v[t][i].z; d[3] = v[t][i].w; }
        LDS_WAIT(); asm volatile("" ::: "memory");
        const int n = lane >> 1, hf = lane & 1; const LAS float* s = scr + (32 * hf) * 33 + n;
        v4u o0, o1;
#pragma unroll
        for (int j = 0; j < 4; ++j) { o0[j] = pk4_fp8(s[(4 * j) * 33] * scale, s[(4 * j + 1) * 33] * scale, s[(4 * j + 2) * 33] * scale, s[(4 * j + 3) * 33] * scale);
            o1[j] = pk4_fp8(s[(16 + 4 * j) * 33] * scale, s[(17 + 4 * j) * 33] * scale, s[(18 + 4 * j) * 33] * scale, s[(19 + 4 * j) * 33] * scale); }
        GAS v4u* d = (GAS v4u*)(WT + (size_t)(n0 + n) * K + k0 + 32 * hf); d[0] = o0; d[1] = o1;
        LDS_WAIT(); asm volatile("" ::: "memory"); }
}
struct MapId { __device__ __forceinline__ int operator()(int n) const { return n; } };
__device__ __forceinline__ int win_route(int n, bool& is16) {
    if (n < 6144) { is16 = false; return n; }
    if (n < 7168) { is16 = true; return n - 6144; }
    if (n < 7232) { is16 = true; return 1024 + (n - 7168); }
    if (n < 7248) { is16 = true; return 1088 + (n - 7232); }
    is16 = false; return 6144 + (n - 7248);
}
__device__ __forceinline__ void transpose_item_win(const float* W, bf16* WT16, unsigned char* WT8, LAS float* scr, int item, int lane) {
    constexpr int K = D, N = NIN;
    const int nblk = (N + 31) / 32, kb = item / nblk, nb = item % nblk, k0 = 64 * kb, n0 = 32 * nb;
    { f32x4 v[8]; const int c4 = (lane & 7) * 4, kr = lane >> 3; const bool ok = n0 + c4 < N;
#pragma unroll
      for (int i = 0; i < 8; ++i) v[i] = ok ? *(const f32x4*)(W + (size_t)(k0 + 8 * i + kr) * N + n0 + c4) : (f32x4){0.f, 0.f, 0.f, 0.f};
#pragma unroll
      for (int i = 0; i < 8; ++i) { LAS float* d = scr + (8 * i + kr) * 33 + c4; d[0] = v[i].x; d[1] = v[i].y; d[2] = v[i].z; d[3] = v[i].w; } }
    LDS_WAIT(); asm volatile("" ::: "memory");
    { const int c = lane & 7;
#pragma unroll
      for (int j = 0; j < 4; ++j) { const int n = (lane >> 3) + 8 * j; const LAS float* s = scr + (8 * c) * 33 + n; bool is16; const int row = win_route(n0 + n, is16);
          v4u o; o.x = pk2(s[0 * 33], s[1 * 33]); o.y = pk2(s[2 * 33], s[3 * 33]); o.z = pk2(s[4 * 33], s[5 * 33]); o.w = pk2(s[6 * 33], s[7 * 33]);
          if (n0 + n < N && is16) *(GAS v4u*)(WT16 + (size_t)row * K + k0 + 8 * c) = o; } }
    { const int n = lane >> 1, hf = lane & 1; const LAS float* s = scr + (32 * hf) * 33 + n; bool is16; const int row = win_route(n0 + n, is16);
      v4u o0, o1;
#pragma unroll
      for (int j = 0; j < 4; ++j) { o0[j] = pk4_fp8(s[(4 * j) * 33] * WIN_FP8_SCALE, s[(4 * j + 1) * 33] * WIN_FP8_SCALE, s[(4 * j + 2) * 33] * WIN_FP8_SCALE, s[(4 * j + 3) * 33] * WIN_FP8_SCALE);
          o1[j] = pk4_fp8(s[(16 + 4 * j) * 33] * WIN_FP8_SCALE, s[(17 + 4 * j) * 33] * WIN_FP8_SCALE, s[(18 + 4 * j) * 33] * WIN_FP8_SCALE, s[(19 + 4 * j) * 33] * WIN_FP8_SCALE); }
      if (n0 + n < N && !is16) { GAS v4u* d = (GAS v4u*)(WT8 + (size_t)row * K + k0 + 32 * hf); d[0] = o0; d[1] = o1; } }
    LDS_WAIT(); asm volatile("" ::: "memory");
}
constexpr int WI_IN = 16 * 291, WI_SQ = 16 * 32, WI_E1 = 16 * 64, WI_E2 = 16 * 32;
constexpr int W_EARLY = WI_IN + 3 * WI_SQ, W_LATE = NE * WI_E1 + NE * WI_E2;
__device__ __forceinline__ void weight_items(Frame& F, int qword, int lo, int hi) {
    LAS float* scr = (LAS float*)(F.lds + RING_OFF + F.wave * 16384);
    LAS int* qw = (LAS int*)(F.lds + L_QI);
    for (;;) {
        __syncthreads();
        if (F.tid == 0) qw[0] = (int)__hip_atomic_fetch_add(F.ctl + qword, 64u, RLX_AGENT);
        __syncthreads();
        const int base = lo + qw[0];
        if (base >= hi) break;
        if (base >= W_EARLY) {
#pragma unroll 1
            for (int k = 0; k < 8; k += 4) { int r = base + F.wave * 8 + k - W_EARLY; if (r + W_EARLY >= hi) break;
                if (r < NE * WI_E1) { const int e = r / WI_E1; transpose_items_fp8<4>(FIN(F, 17) + (size_t)e * D * 2 * FF, D, 2 * FF, (unsigned char*)(F.ws + WS_W1) + (size_t)e * 2 * FF * D, scr, r % WI_E1, F.lane, W1_FP8_SCALE); }
                else { r -= NE * WI_E1; const int e = r / WI_E2; transpose_items_fp8<4>(FIN(F, 19) + (size_t)e * FF * D, FF, D, (unsigned char*)(F.ws + WS_W2) + (size_t)e * D * FF, scr, r % WI_E2, F.lane, W2_FP8_SCALE); } }
            continue; }
#pragma unroll 1
        for (int k = 0; k < 8; ++k) {
        int r = base + F.wave * 8 + k; if (r >= hi) break;
        if (r < WI_IN) { transpose_item_win(FIN(F, 4), (bf16*)(F.ws + WS_WIN), (unsigned char*)(F.ws + WS_WIN8), scr, r, F.lane); continue; } r -= WI_IN;
        if (r < WI_SQ) { transpose_item_fp8(FIN(F, 10), D, D, (unsigned char*)(F.ws + WS_WA), scr, r, F.lane, WAB_FP8_SCALE); continue; } r -= WI_SQ;
        if (r < WI_SQ) { transpose_item_fp8(FIN(F, 11), D, D, (unsigned char*)(F.ws + WS_WB), scr, r, F.lane, WAB_FP8_SCALE); continue; } r -= WI_SQ;
        if (r < WI_SQ) { transpose_item_fp8(FIN(F, 12), D, D, (unsigned char*)(F.ws + WS_WO), scr, r, F.lane, WO_FP8_SCALE); continue; } r -= WI_SQ;
        if (r < NE * WI_E1) { const int e = r / WI_E1; transpose_item_fp8(FIN(F, 17) + (size_t)e * D * 2 * FF, D, 2 * FF, (unsigned char*)(F.ws + WS_W1) + (size_t)e * 2 * FF * D, scr, r % WI_E1, F.lane, W1_FP8_SCALE); continue; } r -= NE * WI_E1;
        { const int e = r / WI_E2; transpose_item_fp8(FIN(F, 19) + (size_t)e * FF * D, FF, D, (unsigned char*)(F.ws + WS_W2) + (size_t)e * D * FF, scr, r % WI_E2, F.lane, W2_FP8_SCALE); }
        }
    }
    __syncthreads();
}
__device__ __forceinline__ void p0_weights(Frame& F) { weight_items(F, CW_P0, 0, W_EARLY); }
__device__ __forceinline__ void ln_mod_row(const float* xrow, bf16* orow, unsigned char* orow8, const float* sc, const float* sh, int lane) {
    const f32x4* xr = (const f32x4*)xrow + lane;
    f32x4 v[4]; float s = 0.f;
#pragma unroll
    for (int j = 0; j < 4; ++j) { v[j] = xr[64 * j]; s += (v[j].x + v[j].y) + (v[j].z + v[j].w); }
    const float mean = wave_sum(s) * (1.f / D); float s2 = 0.f;
#pragma unroll
    for (int j = 0; j < 4; ++j) { v[j] = v[j] - mean; s2 += (v[j].x * v[j].x + v[j].y * v[j].y) + (v[j].z * v[j].z + v[j].w * v[j].w); }
    const float rstd = 1.f / sqrtf(wave_sum(s2) * (1.f / D) + LN_EPS);
    unsigned long long* o8 = (unsigned long long*)orow + lane;
#pragma unroll
    for (int j = 0; j < 4; ++j) { const f32x4 a = *((const f32x4*)sc + lane + 64 * j), b = *((const f32x4*)sh + lane + 64 * j);
        const f32x4 y = v[j] * rstd * (a + 1.f) + b;
        o8[64 * j] = (unsigned long long)pk2(y.x, y.y) | ((unsigned long long)pk2(y.z, y.w) << 32);
        ((unsigned*)orow8)[lane + 64 * j] = pk4_fp8(y.x, y.y, y.z, y.w); }
}
__device__ __forceinline__ void p1_lnmod(Frame& F) {
    const float* mod = (const float*)(F.ws + WS_SMALL);
    const int gw = F.bid * NWAVES + F.wave, NGW = F.G * NWAVES;
#ifndef PROBE_DUP
#define PROBE_DUP -1
#endif
    for (int rp_ = 0; rp_ < ((PROBE_DUP == 50) ? 2 : 1); ++rp_)
#pragma unroll 4
    for (int m = gw; m < S; m += NGW) ln_mod_row(FIN(F, 0) + (size_t)m * D, (bf16*)(F.ws + WS_U) + (size_t)m * D, (unsigned char*)(F.ws + WS_U8) + (size_t)m * D, mod + 1024, mod, F.lane);
}

__device__ __forceinline__ void p7_ln_router(Frame& F) {
    const float* mod = (const float*)(F.ws + WS_SMALL);
    const bf16* Y1 = (const bf16*)(F.ws + WS_Y1); unsigned char* VB = (unsigned char*)(F.ws + WS_VB16);
    LAS float* wrt = (LAS float*)(F.lds + RING_OFF);
    LAS unsigned* lcnt = (LAS unsigned*)(F.lds + L_CNT); LAS unsigned* lbase = (LAS unsigned*)(F.lds + L_BASE);
    LAS unsigned* tinfo = (LAS unsigned*)(F.lds + L_TINFO);
    for (int p = F.tid; p < D * NE; p += 512) { const int k = p >> 5, e = p & 31; wrt[e * D + k] = FIN(F, 15)[p]; }
    if (F.tid < 32) lcnt[F.tid] = 0u;
    __syncthreads();
    const int lane = F.lane, gw = F.bid * NWAVES + F.wave, NGW = F.G * NWAVES;
    for (int rp_ = 0; rp_ < ((PROBE_DUP == 50) ? 2 : 1); ++rp_) {
    int it = 0;
    for (int m = gw; m < S; m += NGW, ++it) {
        const v2u* yr = (const v2u*)(Y1 + (size_t)m * D) + lane;
        f32x4 v[4]; float s = 0.f;
#pragma unroll
        for (int j = 0; j < 4; ++j) { const v2u w = yr[64 * j]; v[j] = (f32x4){bflo(w.x), bfhi(w.x), bflo(w.y), bfhi(w.y)}; s += (v[j].x + v[j].y) + (v[j].z + v[j].w); }
        float mean = wave_sum(s) * (1.f / D); float s2 = 0.f;
#pragma unroll
        for (int j = 0; j < 4; ++j) { v[j] = v[j] - mean; s2 += (v[j].x * v[j].x + v[j].y * v[j].y) + (v[j].z * v[j].z + v[j].w * v[j].w); }
        float rstd = 1.f / sqrtf(wave_sum(s2) * (1.f / D) + LN_EPS);
        s = 0.f;
#pragma unroll
        for (int j = 0; j < 4; ++j) { const f32x4 g = *((const f32x4*)FIN(F, 13) + lane + 64 * j), b = *((const f32x4*)FIN(F, 14) + lane + 64 * j);
            v[j] = v[j] * rstd * g + b; s += (v[j].x + v[j].y) + (v[j].z + v[j].w); }
        mean = wave_sum(s) * (1.f / D); s2 = 0.f;
#pragma unroll
        for (int j = 0; j < 4; ++j) { v[j] = v[j] - mean; s2 += (v[j].x * v[j].x + v[j].y * v[j].y) + (v[j].z * v[j].z + v[j].w * v[j].w); }
        rstd = 1.f / sqrtf(wave_sum(s2) * (1.f / D) + LN_EPS);
        unsigned* o4 = (unsigned*)(VB + (size_t)m * D) + lane;
#pragma unroll
        for (int j = 0; j < 4; ++j) { const f32x4 a = *((const f32x4*)(mod + 4096) + lane + 64 * j), b = *((const f32x4*)(mod + 3072) + lane + 64 * j);
            v[j] = v[j] * rstd * (a + 1.f) + b;
            o4[64 * j] = pk4_fp8(v[j].x, v[j].y, v[j].z, v[j].w); }
        float lgv;
        { float a32[NE];
#pragma unroll
          for (int e = 0; e < NE; ++e) { f32x2 a2 = {0.f, 0.f};
#pragma unroll
              for (int j = 0; j < 4; ++j) { const f32x4 wv = *((const LAS f32x4*)(wrt + e * D) + lane + 64 * j);
                  a2 = __builtin_elementwise_fma(__builtin_shufflevector(v[j], v[j], 0, 1), __builtin_shufflevector(wv, wv, 0, 1), a2);
                  a2 = __builtin_elementwise_fma(__builtin_shufflevector(v[j], v[j], 2, 3), __builtin_shufflevector(wv, wv, 2, 3), a2); }
              a32[e] = a2.x + a2.y; if ((e & 3) == 3) __builtin_amdgcn_sched_barrier(0); }
#define RT_STEP(W, BIT) do { const bool up_ = (lane & (BIT)) != 0; _Pragma("unroll") for (int i = 0; i < (W); ++i) { \
              const float send_ = up_ ? a32[i] : a32[i + (W)], keep_ = up_ ? a32[i + (W)] : a32[i]; a32[i] = keep_ + __shfl_xor(send_, (BIT)); } } while (0)
#define RT_SWAP(W, BUILTIN) do { _Pragma("unroll") for (int i = 0; i < (W); ++i) { const auto rr_ = BUILTIN(__float_as_uint(a32[i]), __float_as_uint(a32[i + (W)]), false, false); \
              a32[i] = __uint_as_float(rr_[0]) + __uint_as_float(rr_[1]); } } while (0)
          RT_SWAP(16, __builtin_amdgcn_permlane32_swap); RT_SWAP(8, __builtin_amdgcn_permlane16_swap);
#undef RT_SWAP
          RT_STEP(4, 8); RT_STEP(2, 4); RT_STEP(1, 2);
#undef RT_STEP
          lgv = a32[0] + __shfl_xor(a32[0], 1);
          lgv += FIN(F, 16)[lane >> 1]; }
        int ei[4]; float ev[4];
        unsigned lgu = idx::ord(lgv);
#pragma unroll
        for (int k = 0; k < 4; ++k) { const unsigned m = idx::wave_umax(lgu);
            const unsigned long long bal = __ballot(lgu == m);
            const int wl_ = (int)__builtin_ctzll(bal) >> 1;
            ei[k] = wl_; ev[k] = idx::unord(m); if ((lane >> 1) == wl_) lgu = idx::ord(-__builtin_inff()); }
        float wsum = 0.f, wk[4];
#pragma unroll
        for (int k = 0; k < 4; ++k) { wk[k] = __expf(ev[k] - ev[0]); wsum += wk[k]; }
        if (lane == 0 && rp_ == 0) {
#pragma unroll
            for (int k = 0; k < 4; ++k) { const unsigned lp = __hip_atomic_fetch_add(&lcnt[ei[k]], 1u, __ATOMIC_RELAXED, __HIP_MEMORY_SCOPE_WORKGROUP);
                LAS unsigned* t = tinfo + ((F.wave * 8 + it) * 4 + k) * 3; t[0] = (unsigned)ei[k]; t[1] = lp; t[2] = __float_as_uint(wk[k] / wsum); }
        }
    } }
    __syncthreads();
    if (F.tid < 32) lbase[F.tid] = __hip_atomic_fetch_add(F.ctl + CW_ECNT + F.tid, lcnt[F.tid], RLX_AGENT);
    __syncthreads();
    if (F.tid < 256) { const int wv = F.tid >> 5, i2 = (F.tid >> 2) & 7, k = F.tid & 3; const int m = (F.bid * NWAVES + wv) + NGW * i2;
        if (m < S) { const LAS unsigned* t = tinfo + ((wv * 8 + i2) * 4 + k) * 3;
            const int e = (int)t[0], pos = (int)(lbase[t[0]] + t[1]);
            ((int*)(F.ws + WS_TOKE))[m * 4 + k] = e; ((int*)(F.ws + WS_TOKP))[m * 4 + k] = pos;
            ((int*)(F.ws + WS_IDXTOK))[(size_t)e * S + pos] = m; ((unsigned*)(F.ws + WS_IDXW))[(size_t)e * S + pos] = t[2]; } }
    __syncthreads();
}
__device__ __forceinline__ void moe_tables(Frame& F) {
    LAS unsigned* off = (LAS unsigned*)(F.lds + L_OFF); LAS unsigned char* texp = (LAS unsigned char*)(F.lds + L_TEXP); LAS int* nt = (LAS int*)(F.lds + L_NT);
    if (F.tid < 64) {
        const int e = F.lane & 31;
        const unsigned c = __hip_atomic_load(F.ctl + CW_ECNT + e, RLX_AGENT);
        const int nte = (F.lane < 32) ? (int)((c + 255u) >> 8) : 0;
        int incl = nte;
#pragma unroll
        for (int o = 1; o < 32; o <<= 1) { const int v = __shfl_up(incl, o); if ((F.lane & 31) >= o) incl += v; }
        const int excl = incl - nte;
        if (F.lane < 32) { ((LAS unsigned*)(F.lds + L_CNT))[e] = c; off[e] = (unsigned)excl << 8; for (int i = 0; i < nte; ++i) if (excl + i < 288) texp[excl + i] = (unsigned char)e; }
        if (F.lane == 31) { off[NE] = (unsigned)incl << 8; nt[0] = incl < 288 ? incl : 288; }
    }
    __syncthreads();
}
__device__ __forceinline__ void p8_dispatch(Frame& F) {
    moe_tables(F);
    const LAS unsigned* off = (const LAS unsigned*)(F.lds + L_OFF);
    const unsigned char* VB = (const unsigned char*)(F.ws + WS_VB16); unsigned char* XS = (unsigned char*)(F.ws + WS_XS);
    const int lane = F.lane, gw = F.bid * NWAVES + F.wave, NGW = F.G * NWAVES;
    for (int rp_ = 0; rp_ < ((PROBE_DUP == 50) ? 2 : 1); ++rp_)
    for (int m = gw; m < S; m += NGW) {
        const v4u a = *((const v4u*)(VB + (size_t)m * D) + lane);
#pragma unroll
        for (int k = 0; k < 4; ++k) { const int e = ((const int*)(F.ws + WS_TOKE))[m * 4 + k], p = ((const int*)(F.ws + WS_TOKP))[m * 4 + k];
            const int slot = (int)off[e] + p;
            *((v4u*)(XS + (size_t)slot * D) + lane) = a;
            if (lane == 0) { ((int*)(F.ws + WS_TOKSLOT))[m * 4 + k] = slot; ((float*)(F.ws + WS_SLOTW))[slot] = ((const float*)(F.ws + WS_TOKW))[m * 4 + k]; } }
    }
}
__device__ __forceinline__ void p11_final(Frame& F) {
    moe_tables(F);
    const float* mod = (const float*)(F.ws + WS_SMALL);
    const bf16* Y1 = (const bf16*)(F.ws + WS_Y1); const unsigned char* O2 = (const unsigned char*)(F.ws + WS_OUT2);
    const int lane = F.lane, gw = F.bid * NWAVES + F.wave, NGW = F.G * NWAVES;
    for (int rp_ = 0; rp_ < ((PROBE_DUP == 50) ? 2 : 1); ++rp_)
#pragma unroll 2
    for (int m = gw; m < S; m += NGW) {
        f32x4 f[4];
#pragma unroll
        for (int j = 0; j < 4; ++j) f[j] = (f32x4){0.f, 0.f, 0.f, 0.f};
#pragma unroll
        for (int k = 0; k < 4; ++k) { const int slot = (int)((const LAS unsigned*)(F.lds + L_OFF))[((const int*)(F.ws + WS_TOKE))[m * 4 + k]] + ((const int*)(F.ws + WS_TOKP))[m * 4 + k];
            const unsigned* r = (const unsigned*)(O2 + (size_t)slot * D) + lane;
#pragma unroll
            for (int j = 0; j < 4; ++j) { const int w = (int)r[64 * j];
                f[j].x += __builtin_amdgcn_cvt_f32_fp8(w, 0); f[j].y += __builtin_amdgcn_cvt_f32_fp8(w, 1); f[j].z += __builtin_amdgcn_cvt_f32_fp8(w, 2); f[j].w += __builtin_amdgcn_cvt_f32_fp8(w, 3); } }
        f32x4 v[4]; float s = 0.f;
        { const v2u* yr = (const v2u*)(Y1 + (size_t)m * D) + lane;
#pragma unroll
          for (int j = 0; j < 4; ++j) { const v2u w = yr[64 * j]; v[j] = (f32x4){bflo(w.x), bfhi(w.x), bflo(w.y), bfhi(w.y)}; s += (v[j].x + v[j].y) + (v[j].z + v[j].w); }
          const float mean1 = wave_sum(s) * (1.f / D); float q1 = 0.f;
#pragma unroll
          for (int j = 0; j < 4; ++j) { v[j] = v[j] - mean1; q1 += (v[j].x * v[j].x + v[j].y * v[j].y) + (v[j].z * v[j].z + v[j].w * v[j].w); }
          const float rstd1 = 1.f / sqrtf(wave_sum(q1) * (1.f / D) + LN_EPS);
#pragma unroll
          for (int j = 0; j < 4; ++j) { const f32x4 g = *((const f32x4*)FIN(F, 13) + lane + 64 * j), b = *((const f32x4*)FIN(F, 14) + lane + 64 * j); v[j] = v[j] * rstd1 * g + b; } }
        s = 0.f;
#pragma unroll
        for (int j = 0; j < 4; ++j) { const f32x4 g = *((const f32x4*)(mod + 5120) + lane + 64 * j);
            v[j] = v[j] * ALPHA + g * (f[j] * (1.f / O2_FP8_SCALE)); s += (v[j].x + v[j].y) + (v[j].z + v[j].w); }
        const float mean = wave_sum(s) * (1.f / D); float s2 = 0.f;
#pragma unroll
        for (int j = 0; j < 4; ++j) { v[j] = v[j] - mean; s2 += (v[j].x * v[j].x + v[j].y * v[j].y) + (v[j].z * v[j].z + v[j].w * v[j].w); }
        const float rstd = 1.f / sqrtf(wave_sum(s2) * (1.f / D) + LN_EPS);
#pragma unroll
        for (int j = 0; j < 4; ++j) { const f32x4 g = *((const f32x4*)FIN(F, 21) + lane + 64 * j), b = *((const f32x4*)FIN(F, 22) + lane + 64 * j);
            *((f32x4*)(F.ap->out + (size_t)m * D) + lane + 64 * j) = v[j] * rstd * g + b; }
    }
}

constexpr int NPHASE = 12;

__device__ __forceinline__ int queue_next(Frame& F, int word) {
    __syncthreads();
    if (F.tid == 0) *(LAS int*)(F.lds + L_QI) = (int)__hip_atomic_fetch_add(F.ctl + word, 1u, RLX_AGENT);
    __syncthreads();
    return *(LAS int*)(F.lds + L_QI);
}

__global__ void __launch_bounds__(NWAVES * 64, 2) block_fwd(Args args) {
    extern __shared__ __attribute__((aligned(16))) unsigned char lds[];
    Frame F;
    F.lds = (LAS unsigned char*)lds;
    F.MISC = (volatile LAS unsigned*)(F.lds + MISC_OFF);
    F.tid = threadIdx.x; F.lane = F.tid & 63; F.wave = __builtin_amdgcn_readfirstlane(F.tid >> 6);
    F.G = gridDim.x; F.bid = blockIdx.x;
    F.ws = args.ws; F.ctl = (gu32*)(args.ws + WS_CTL);
    F.ap = kargs();
    for (int u = F.tid; u < (LDS_BYTES - LDSCTL_OFF) / 4; u += NWAVES * 64) ((LAS unsigned*)(F.lds + LDSCTL_OFF))[u] = 0u;
    __syncthreads();
#if MK_ONE_LAUNCH
    XcdBarrier bar = xcd_barrier_post((unsigned*)(F.ctl + CW_BAR), F.MISC + 8);
#define GRID_BAR() xcd_barrier(bar)
#else
#define GRID_BAR() do {} while (0)
#endif
    const int lo = args.ph_lo, hi = args.ph_hi;
#ifndef PH_MASK
#define PH_MASK 0xfff
#endif
#define IN(k) (((PH_MASK >> (k)) & 1) && lo <= (k) && (k) < hi)
#define SEAM(k) do { if (IN(k) && IN((k) + 1)) { GRID_BAR(); if (PROBE_DUP == 60) GRID_BAR(); } } while (0)
#ifndef PROBE_DUP
#define PROBE_DUP -1
#endif
#define REPS(k)
#define PMUL(k) (((PROBE_DUP == (k)) || (PROBE_DUP == 42 && ((k) == 40 || (k) == 41))) ? 2 : 1)
    constexpr int rep = 0;
    bf16* PROJ = (bf16*)(F.ws + WS_PROJ);

    if (IN(0)) { F.ap = kargs(); p0_mod(F); p0_weights(F); }
    SEAM(0);
    if (IN(1)) { F.ap = kargs(); p1_lnmod(F); }
    SEAM(1);
    if (IN(2)) { F.ap = kargs();
        { pg8::Gemm g{(const pg8::bf16_t*)(F.ws + WS_U8), (const pg8::bf16_t*)(F.ws + WS_WIN8), S, NPROJ8, D / 2}; pg8::StaticOrder So; So.init(S, NPROJ8, F.G, F.bid);
          epi::EpiProj8 E{PROJ};
          epi::ProjOrder Sp{So}; epi::RepOrder<epi::ProjOrder> Sr{Sp, Sp.count(), PMUL(2)};
          pg8::gemm_phase<epi::EpiProj8, epi::RepOrder<epi::ProjOrder>, true, true, true>(F.lds + RING_OFF, g, Sr, E); }
        __syncthreads();
        { pg8::Gemm g{(const pg8::bf16_t*)(F.ws + WS_U), (const pg8::bf16_t*)(F.ws + WS_WIN), S, NPROJ16, D}; pg8::StaticOrder So; So.init(S, NPROJ16, F.G, F.bid);
          epi::EpiProjIdx E{PROJ + 6 * PROJ_STRIDE, (bf16*)(F.ws + WS_KI), (float*)(F.ws + WS_WI)};
          epi::RepOrder<pg8::StaticOrder> Sr{So, So.c < So.nwg ? (So.nwg - So.c + So.G - 1) / So.G : 0, PMUL(2)};
          pg8::gemm_phase<epi::EpiProjIdx, epi::RepOrder<pg8::StaticOrder>, true, true>(F.lds + RING_OFF, g, Sr, E); }
    }
    SEAM(2);
    if (IN(3)) { F.ap = kargs();
        for (;;) { const int i = queue_next(F, CW_Q3 + 64 * rep); if (i >= 1024 * PMUL(3)) break; idx::index_unit(F, 1023 - (i & 1023)); }
        p3_norms(F);
        F.ap = kargs(); weight_items(F, CW_P0 + 16, W_EARLY, W_EARLY + W_LATE / 2);
        __syncthreads();
    }
    SEAM(3);
    if (IN(4)) { F.ap = kargs();
        float lam;
        { float a = 0.f, b = 0.f;
          for (int i = 0; i < 64; ++i) { a += FIN(F, 5)[i] * FIN(F, 6)[i]; b += FIN(F, 7)[i] * FIN(F, 8)[i]; }
          lam = __expf(a) - __expf(b) + LAM_INIT; }
#define DSA_LOOP() do { build_order(F, 1); \
            for (int i = queue_next(F, CW_Q4S + 64 * rep); i < 512 * PMUL(41); ) { \
                const int u = (int)(((LAS unsigned*)(F.lds + L_ORDER))[i & 511] & 0xffffu); \
                dsa_unit(F, (char*)lds, u >> 6, u & 63, CW_Q4S + 64 * rep); \
                __syncthreads(); i = __builtin_amdgcn_readfirstlane(*(LAS int*)(F.lds + L_QI)); } } while (0)
#ifndef NO_DSA
        if (F.bid & 1) DSA_LOOP();
#endif
#ifndef NO_DIFF
        build_order(F, 0);
        for (int i = queue_next(F, CW_Q4D + 64 * rep); i < 1024 * PMUL(40); ) {
            const int u = (int)(((LAS unsigned*)(F.lds + L_ORDER))[i & 1023] & 0xffffu);
            diff_unit(F, (char*)lds, (u >> 6) & 7, u & 63, u >> 9, CW_Q4D + 64 * rep);
            __syncthreads(); i = __builtin_amdgcn_readfirstlane(*(LAS int*)(F.lds + L_QI)); }
#endif
#ifndef NO_DSA
        if (!(F.bid & 1)) DSA_LOOP();
#endif
#undef DSA_LOOP
        F.ap = kargs(); weight_items(F, CW_P0 + 32, W_EARLY + W_LATE / 2, W_EARLY + W_LATE);
        GRID_BAR();
        p4c_combine(F, lam);
        __syncthreads();
    }
    SEAM(4);
    if (IN(5)) { F.ap = kargs();
        pg8::StaticOrder So; So.init(S, D, F.G, F.bid);
        { pg8::Gemm g{(const pg8::bf16_t*)(F.ws + WS_YA), (const pg8::bf16_t*)(F.ws + WS_WA), S, D, D / 2};
          epi::EpiGateA E{PROJ + 7 * PROJ_STRIDE, (float*)(F.ws + WS_T1)};
          pg8::gemm_phase<epi::EpiGateA, pg8::StaticOrder, true, true, true>(F.lds + RING_OFF, g, So, E); }
        __syncthreads();
        { pg8::Gemm g{(const pg8::bf16_t*)(F.ws + WS_YB), (const pg8::bf16_t*)(F.ws + WS_WB), S, D, D / 2};
          epi::EpiGateB E{PROJ + 8 * PROJ_STRIDE, (const float*)(F.ws + WS_T1), (unsigned char*)(F.ws + WS_MG)};
          pg8::gemm_phase<epi::EpiGateB, pg8::StaticOrder, true, true, true>(F.lds + RING_OFF, g, So, E); }
    }
    SEAM(5);
    if (IN(6)) { F.ap = kargs();
        pg8::Gemm g{(const pg8::bf16_t*)(F.ws + WS_MG), (const pg8::bf16_t*)(F.ws + WS_WO), S, D, D / 2}; pg8::StaticOrder So; So.init(S, D, F.G, F.bid);
        epi::EpiOut E{FIN(F, 0), (const float*)(F.ws + WS_SMALL) + 2048, (bf16*)(F.ws + WS_Y1)};
        pg8::gemm_phase<epi::EpiOut, pg8::StaticOrder, true, true, true>(F.lds + RING_OFF, g, So, E);
    }
    SEAM(6);
    if (IN(7)) { F.ap = kargs(); p7_ln_router(F); }
    SEAM(7);
    if (IN(9)) { F.ap = kargs();
        moe_tables(F);
        pg8::Gemm g{(const pg8::bf16_t*)(F.ws + WS_VB16), (const pg8::bf16_t*)(F.ws + WS_W1), MAXSLOT, NE * 2 * FF, D / 2};
        epi::MoeOrder So{(const LAS unsigned char*)(F.lds + L_TEXP), *(LAS int*)(F.lds + L_NT), 8, F.G, F.bid, (const int*)(F.ws + WS_IDXTOK), (const LAS unsigned*)(F.lds + L_OFF), (const LAS unsigned*)(F.lds + L_CNT)};
        epi::EpiMoe1 E{FIN(F, 18), (unsigned char*)(F.ws + WS_H)};
        const int tot1 = So.ntiles * So.nN; epi::RepOrder<epi::MoeOrder> Sr{So, So.c < tot1 ? (tot1 - So.c + So.G - 1) / So.G : 0, PMUL(9)};
        pg8::gemm_phase<epi::EpiMoe1, epi::RepOrder<epi::MoeOrder>, true, true, true, true>(F.lds + RING_OFF, g, Sr, E);
    }
    SEAM(9);
    if (IN(10)) { F.ap = kargs();
        moe_tables(F);
        pg8::Gemm g{(const pg8::bf16_t*)(F.ws + WS_H), (const pg8::bf16_t*)(F.ws + WS_W2), MAXSLOT, NE * D, FF / 2};
        epi::MoeOrder So{(const LAS unsigned char*)(F.lds + L_TEXP), *(LAS int*)(F.lds + L_NT), 4, F.G, F.bid, nullptr, (const LAS unsigned*)(F.lds + L_OFF), (const LAS unsigned*)(F.lds + L_CNT)};
        epi::EpiMoe2 E{FIN(F, 20), (const float*)(F.ws + WS_IDXW), (const LAS unsigned*)(F.lds + L_OFF), (unsigned char*)(F.ws + WS_OUT2)};
        const int tot2 = So.ntiles * So.nN; epi::RepOrder<epi::MoeOrder> Sr{So, So.c < tot2 ? (tot2 - So.c + So.G - 1) / So.G : 0, PMUL(10)};
        pg8::gemm_phase<epi::EpiMoe2, epi::RepOrder<epi::MoeOrder>, true, true, true>(F.lds + RING_OFF, g, Sr, E);
    }
    SEAM(10);
    if (IN(11)) { F.ap = kargs(); p11_final(F); }
#undef IN
#undef SEAM
}

extern "C" void kernel_launch(void* const* d_in, const int* in_sizes, int n_in, void* d_out, int out_size, void* d_ws, size_t ws_size, hipStream_t stream) {
    static int grid = 0;
    if (grid == 0) {
        if (n_in != 23 || in_sizes[0] != S * D || out_size != S * D || ws_size < WS_END) {
            fprintf(stderr, "kernel_launch: shape mismatch: n_in %d in0 %d out %d ws %zu (need %zu)\n", n_in, n_in > 0 ? in_sizes[0] : -1, out_size, ws_size, (size_t)WS_END); grid = -1; return; }
        int dev = 0, cus = 0;
        if (hipGetDevice(&dev) != hipSuccess || hipDeviceGetAttribute(&cus, hipDeviceAttributeMultiprocessorCount, dev) != hipSuccess) { fprintf(stderr, "kernel_launch: device query failed\n"); grid = -1; return; }
        if (hipFuncSetAttribute((const void*)block_fwd, hipFuncAttributeMaxDynamicSharedMemorySize, LDS_BYTES) != hipSuccess) { fprintf(stderr, "kernel_launch: hipFuncSetAttribute failed\n"); grid = -1; return; }
        int per_cu = 0;
        if (hipOccupancyMaxActiveBlocksPerMultiprocessor(&per_cu, (const void*)block_fwd, NWAVES * 64, LDS_BYTES) != hipSuccess || per_cu < 1)
            fprintf(stderr, "kernel_launch: note: occupancy query reports %d workgroups per CU\n", per_cu);
        (void)hipGetLastError();
        if (cus != 256) { fprintf(stderr, "kernel_launch: built for 256 CUs, device has %d\n", cus); grid = -1; return; }
        grid = 256;
    }
    if (grid < 0) return;
    if (hipMemsetAsync((char*)d_ws + WS_CTL, 0, CTL_ZERO_BYTES, stream) != hipSuccess) { fprintf(stderr, "kernel_launch: memset failed\n"); return; }
    Args a{};
    for (int i = 0; i < 23; ++i) a.in[i] = (const float*)d_in[i];
    a.out = (float*)d_out; a.ws = (unsigned char*)d_ws;
#if MK_ONE_LAUNCH
    a.ph_lo = 0; a.ph_hi = NPHASE;
    hipLaunchKernelGGL(block_fwd, dim3(grid), dim3(NWAVES * 64), LDS_BYTES, stream, a);
#else
    for (int p = 0; p < NPHASE; ++p) { a.ph_lo = p; a.ph_hi = p + 1;
        hipLaunchKernelGGL(block_fwd, dim3(grid), dim3(NWAVES * 64), LDS_BYTES, stream, a); }
#endif
    const hipError_t le = hipPeekAtLastError();
    if (le != hipSuccess) fprintf(stderr, "kernel_launch: launch failed: %s\n", hipGetErrorName(le));
}
```

```cpp
#include <hip/hip_runtime.h>
#include <hip/hip_bf16.h>
#include <cstdio>
#include <cstdint>
#include <cmath>

#ifndef MK_ONE_LAUNCH
#define MK_ONE_LAUNCH 1
#endif

#ifndef PROBE_DUP
#define PROBE_DUP -1
#endif
namespace pg8 {
#define PG8_LAS __attribute__((address_space(3)))
typedef unsigned short bf16_t;
typedef short bf16x8 __attribute__((ext_vector_type(8)));
typedef float f32x4 __attribute__((ext_vector_type(4)));
typedef unsigned u32x4 __attribute__((ext_vector_type(4)));
typedef int i32x4_t __attribute__((ext_vector_type(4)));
typedef int i32x8_t __attribute__((ext_vector_type(8)));
constexpr int BM = 256, BK = 64, HALF = 128, HTB = HALF * BK * 2  , STAGE_BYTES = 8 * HTB, NXCD = 8, WGM = 8;

__host__ __device__ __forceinline__ int lds_byte(int r, int c) { const int st = (r >> 4) * 2 + (c >> 5), rr = r & 15, cc = c & 31, ob = rr * 64 + cc * 2; return st * 1024 + (ob ^ (((ob >> 9) & 1) << 5)); }
__host__ __device__ __forceinline__ void stage_rc(int b, int& R, int& C) { const int st = b / 1024, sb = b % 1024, swz = sb ^ (((sb >> 9) & 1) << 5); R = (st >> 1) * 16 + swz / 64; C = (st & 1) * 32 + (swz % 64) / 2; }
__host__ __device__ __forceinline__ int perm32(int rho) { const int n = rho >> 4, i = rho & 15; return 8 * (i >> 2) + 4 * n + (i & 3); }

struct Unit { int pm, pn; };
struct Gemm { const bf16_t* A; const bf16_t* Bt; int M, N, K; };

struct StaticOrder {
    int nM, nN, nwg, G, c;
    __host__ __device__ void init(int M, int N, int G_, int c_) { nM = M / BM; nN = N / BM; nwg = nM * nN; G = G_; c = c_; }
    __host__ __device__ bool next(int i, Unit& u) const { return at((long)i * G + c, u); }
    __host__ __device__ bool at(long L, Unit& u) const {
        if (L >= nwg) return false;
        int wgid = (int)L; { const int q = nwg / NXCD, r = nwg % NXCD, xcd = wgid % NXCD, off = wgid / NXCD; wgid = (xcd < r ? xcd * (q + 1) : r * (q + 1) + (xcd - r) * q) + off; }
        const int nig = WGM * nN, gid = wgid / nig, fm = gid * WGM, gsz = (nM - fm) < WGM ? (nM - fm) : WGM;
        u.pm = fm + ((wgid % nig) % gsz); u.pn = (wgid % nig) / gsz; return true;
    }
    __device__ __forceinline__ void a_ready(const Unit&) const {}
    __device__ __forceinline__ void done(const Unit&) const {}
};

__device__ __forceinline__ unsigned cvt_pk_bf16(float lo, float hi) { unsigned r; asm volatile("v_cvt_pk_bf16_f32 %0, %1, %2" : "=v"(r) : "v"(lo), "v"(hi)); return r; }
typedef float f32x2 __attribute__((ext_vector_type(2)));
template <class Epi, class Sched, bool ALIGN_EPI = false, bool SP2 = false, bool FP8 = false, bool GATHER = false>
__device__ __forceinline__ void gemm_phase(PG8_LAS unsigned char* lds, const Gemm g, const Sched& S, const Epi& E) {
    const int tid = threadIdx.x, wid = __builtin_amdgcn_readfirstlane(tid >> 6), lane = tid & 63, wr = wid >> 2, wc = wid & 3, fr = lane & 15, fq = lane >> 4;
    const int K = g.K; int nt_ = K / BK; if constexpr (FP8) asm volatile("" : "+s"(nt_));
    const int nt = nt_;
    static_assert(!GATHER || SP2, "GATHER is written for the SP2 loop");
    unsigned voffA[2], voffB[2]; int rowA[2]; unsigned colA[2];
#pragma unroll
    for (int i = 0; i < 2; ++i) { int R, C; stage_rc(tid * 16 + i * 8192, R, C); const int Rb = Epi::PERM ? ((R & ~31) + perm32(R & 31)) : R;
        voffA[i] = (unsigned)(R * K + C) * 2u; voffB[i] = (unsigned)(Rb * K + C) * 2u; rowA[i] = R; colA[i] = (unsigned)C * 2u; }
    const unsigned rowbytes = (unsigned)K * 2u;
    unsigned gC[2][2], tokN[2][2];
#define PG8_GLOAD(u_) do { _Pragma("unroll") for (int h_ = 0; h_ < 2; ++h_) _Pragma("unroll") for (int i_ = 0; i_ < 2; ++i_) { const int* p_ = S.row_ptr(u_, h_ * HALF + rowA[i_]); \
        asm volatile("global_load_dword %0, %1, off" : "=v"(tokN[h_][i_]) : "v"(p_) : "memory"); } } while (0)
#define PG8_GSETTLE() do { asm volatile("" : "+v"(tokN[0][0]), "+v"(tokN[0][1]), "+v"(tokN[1][0]), "+v"(tokN[1][1])); \
        _Pragma("unroll") for (int h_ = 0; h_ < 2; ++h_) _Pragma("unroll") for (int i_ = 0; i_ < 2; ++i_) gN[h_][i_] = tokN[h_][i_] * rowbytes + colA[i_]; } while (0)
#define PG8_STGA(b_, h_, kp_, ko_, G_) do { if constexpr (GATHER) PG8_STAGE(PG8_SA(b_, h_), (const char*)g.A + (ko_), G_[h_]); else PG8_STAGE(PG8_SA(b_, h_), (kp_) + (h_) * hstep, voffA); } while (0)
    const size_t kstep = (size_t)(BK * 2);
    const size_t hstep = (size_t)HALF * K * 2;
    const size_t tstep = 2 * hstep;
    const unsigned ldsw = (unsigned)wid * 1024u;
    const int aoff = lds_byte(wr * 64 + fr, fq * 8), boff = lds_byte(wc * 32 + fr, fq * 8);
#define PG8_SA(b, h) (((b) * 2 + (h)) * HTB)
#define PG8_SB(b, h) ((4 + (b) * 2 + (h)) * HTB)
#define PG8_STAGE(bufoff, gbase, voff) do { _Pragma("unroll") for (int _i = 0; _i < 2; ++_i) \
        __builtin_amdgcn_global_load_lds((const unsigned*)((const char*)(gbase) + (voff)[_i]), (PG8_LAS unsigned*)(lds + (bufoff) + ldsw + _i * 8192), 16, 0, 0); } while (0)
#define PG8_LD8(off_) __builtin_shufflevector(*(const PG8_LAS i32x4_t*)(lds + (off_)), *(const PG8_LAS i32x4_t*)(lds + (off_) + 1024), 0, 1, 2, 3, 4, 5, 6, 7)
#define PG8_LDA(dst, b, h) do { _Pragma("unroll") for (int m = 0; m < 4; ++m) { if constexpr (FP8) dst##8[m] = PG8_LD8(PG8_SA(b, h) + aoff + m * 2048); \
        else { _Pragma("unroll") for (int k = 0; k < 2; ++k) dst[m][k] = *(const PG8_LAS bf16x8*)(lds + PG8_SA(b, h) + aoff + m * 2048 + k * 1024); } } } while (0)
#define PG8_LDB(dst, b, h) do { _Pragma("unroll") for (int n = 0; n < 2; ++n) { if constexpr (FP8) dst##8[n] = PG8_LD8(PG8_SB(b, h) + boff + n * 2048); \
        else { _Pragma("unroll") for (int k = 0; k < 2; ++k) dst[n][k] = *(const PG8_LAS bf16x8*)(lds + PG8_SB(b, h) + boff + n * 2048 + k * 1024); } } } while (0)
#define PG8_MMA(ai, bj, At, Bt) do { __builtin_amdgcn_s_setprio(1); _Pragma("unroll") for (int m = 0; m < 4; ++m) _Pragma("unroll") for (int n = 0; n < 2; ++n) { \
        if constexpr (FP8) asm volatile("v_mfma_scale_f32_16x16x128_f8f6f4 %0, %1, %2, %0, %3, %3 op_sel_hi:[0,0,0]" : "+v"(acc[ai][bj][m][n]) : "v"(Bt##8[n]), "v"(At##8[m]), "v"(fp8_unit_scale));   \
        else { _Pragma("unroll") for (int k = 0; k < 2; ++k) acc[ai][bj][m][n] = __builtin_amdgcn_mfma_f32_16x16x32_bf16(Bt[n][k], At[m][k], acc[ai][bj][m][n], 0, 0, 0); } } \
        __builtin_amdgcn_s_setprio(0); } while (0)
#define PG8_WAIT_V(n) asm volatile("s_waitcnt vmcnt(" #n ")" ::: "memory")
#define PG8_WAIT_L(n) asm volatile("s_waitcnt lgkmcnt(" #n ")" ::: "memory")
#define PG8_BAR __builtin_amdgcn_s_barrier()
#define PG8_SCHED __builtin_amdgcn_sched_barrier(0)
    Unit cur, nxt; int ui = 0;
    if (!S.next(0, cur)) return;
    f32x4 acc[2][2][4][2];
#pragma unroll
    for (int a = 0; a < 2; ++a)
#pragma unroll
        for (int b = 0; b < 2; ++b)
#pragma unroll
            for (int m = 0; m < 4; ++m)
#pragma unroll
                for (int n = 0; n < 2; ++n) acc[a][b][m][n] = (f32x4){0.f, 0.f, 0.f, 0.f};
    int fp8_unit_scale = 0x7f7f7f7f; asm volatile("" : "+v"(fp8_unit_scale));
    bf16x8 At[4][2], B0[2][2], B1[2][2]; i32x8_t At8[4], B08[2], B18[2];
    const char* cA = (const char*)g.A + (size_t)cur.pm * tstep; const char* cB = (const char*)g.Bt + (size_t)cur.pn * tstep;
    S.a_ready(cur);
    if constexpr (SP2) {
        if constexpr (GATHER) { unsigned gN[2][2]; PG8_GLOAD(cur); asm volatile("s_waitcnt vmcnt(0)" ::: "memory"); PG8_GSETTLE();
#pragma unroll
            for (int h_ = 0; h_ < 2; ++h_) { gC[h_][0] = gN[h_][0]; gC[h_][1] = gN[h_][1]; } }
        PG8_STAGE(PG8_SB(0, 0), cB, voffB); PG8_STAGE(PG8_SB(0, 1), cB + hstep, voffB); PG8_STGA(0, 0, cA, 0, gC); PG8_STGA(0, 1, cA, 0, gC);
        if (wr == 1) PG8_BAR;
        PG8_WAIT_V(2); PG8_BAR;
        PG8_STAGE(PG8_SB(1, 0), cB + kstep, voffB); PG8_STGA(1, 0, cA + kstep, kstep, gC); PG8_STAGE(PG8_SB(1, 1), cB + hstep + kstep, voffB);
        PG8_WAIT_V(6); PG8_BAR;
    } else {
        PG8_STAGE(PG8_SB(0, 0), cB, voffB); PG8_STAGE(PG8_SA(0, 0), cA, voffA); PG8_STAGE(PG8_SB(0, 1), cB + hstep, voffB); PG8_STAGE(PG8_SA(0, 1), cA + hstep, voffA);
        if (wr == 1) PG8_BAR;
        PG8_WAIT_V(4); PG8_BAR;
        PG8_STAGE(PG8_SB(1, 0), cB + kstep, voffB); PG8_STAGE(PG8_SA(1, 0), cA + kstep, voffA); PG8_STAGE(PG8_SB(1, 1), cB + hstep + kstep, voffB);
        PG8_WAIT_V(6); PG8_BAR;
    }
    for (;;) {
        const bool has_next = S.next(ui + 1, nxt);
        const char* nA = has_next ? (const char*)g.A + (size_t)nxt.pm * tstep : cA; const char* nB = has_next ? (const char*)g.Bt + (size_t)nxt.pn * tstep : cB;
        if constexpr (GATHER) { if (has_next) PG8_GLOAD(nxt); }
        unsigned gN[2][2];
#pragma unroll
        for (int h_ = 0; h_ < 2; ++h_) { gN[h_][0] = gC[h_][0]; gN[h_][1] = gC[h_][1]; }
        for (int t = 0; t < nt; t += 2) {
            const bool last = (t == nt - 2);
            const size_t ko1 = (size_t)(t + 1) * kstep, ko2 = last ? 0 : (size_t)(t + 2) * kstep, ko3 = ko2 + kstep;
            unsigned gS[2][2];
            if constexpr (GATHER) { if (last && has_next) PG8_GSETTLE();
#pragma unroll
                for (int h_ = 0; h_ < 2; ++h_) { gS[h_][0] = last ? gN[h_][0] : gC[h_][0]; gS[h_][1] = last ? gN[h_][1] : gC[h_][1]; } }
            const char* a1 = cA + (size_t)(t + 1) * kstep;
            const char* a2 = last ? nA : cA + (size_t)(t + 2) * kstep; const char* b2 = last ? nB : cB + (size_t)(t + 2) * kstep;
            const char* a3 = a2 + kstep; const char* b3 = b2 + kstep;
            if (last && has_next) S.a_ready(nxt);
            if constexpr (SP2) {
            PG8_LDB(B0, 0, 0); PG8_LDB(B1, 0, 1); PG8_SCHED; PG8_LDA(At, 0, 0); PG8_STGA(1, 1, a1, ko1, gC);
            PG8_WAIT_V(8); PG8_WAIT_L(0); PG8_BAR; PG8_MMA(0, 0, At, B0); PG8_MMA(0, 1, At, B1); PG8_BAR; PG8_SCHED;
            PG8_LDA(At, 0, 1); PG8_STAGE(PG8_SB(0, 0), b2, voffB); PG8_STAGE(PG8_SB(0, 1), b2 + hstep, voffB); PG8_STGA(0, 0, a2, ko2, gS);
            PG8_WAIT_V(8); PG8_WAIT_L(0); PG8_BAR; PG8_MMA(1, 0, At, B0); PG8_MMA(1, 1, At, B1); PG8_BAR; PG8_SCHED;
            PG8_LDB(B0, 1, 0); PG8_LDB(B1, 1, 1); PG8_SCHED; PG8_LDA(At, 1, 0); PG8_STGA(0, 1, a2, ko2, gS);
            PG8_WAIT_V(8); PG8_WAIT_L(0); PG8_BAR; PG8_MMA(0, 0, At, B0); PG8_MMA(0, 1, At, B1); PG8_BAR; PG8_SCHED;
            PG8_LDA(At, 1, 1); PG8_STAGE(PG8_SB(1, 0), b3, voffB); PG8_STAGE(PG8_SB(1, 1), b3 + hstep, voffB); PG8_STGA(1, 0, a3, ko3, gS);
            PG8_WAIT_V(8); PG8_WAIT_L(0); PG8_BAR; PG8_MMA(1, 0, At, B0); PG8_MMA(1, 1, At, B1); PG8_BAR; PG8_SCHED;
            } else {
            PG8_LDB(B0, 0, 0); PG8_SCHED; PG8_LDA(At, 0, 0); PG8_STAGE(PG8_SA(1, 1), a1 + hstep, voffA);
            PG8_WAIT_L(8); PG8_BAR; PG8_WAIT_L(0); PG8_MMA(0, 0, At, B0); PG8_BAR; PG8_SCHED;
            PG8_LDB(B1, 0, 1); PG8_STAGE(PG8_SB(0, 0), b2, voffB);
            PG8_BAR; PG8_WAIT_L(0); PG8_MMA(0, 1, At, B1); PG8_BAR;
            PG8_LDA(At, 0, 1); PG8_STAGE(PG8_SA(0, 0), a2, voffA);
            PG8_BAR; PG8_WAIT_L(0); PG8_MMA(1, 0, At, B0); PG8_BAR; PG8_SCHED;
            PG8_STAGE(PG8_SB(0, 1), b2 + hstep, voffB);
            PG8_WAIT_V(6); PG8_BAR; PG8_MMA(1, 1, At, B1); PG8_BAR;
            PG8_LDB(B0, 1, 0); PG8_SCHED; PG8_LDA(At, 1, 0); PG8_STAGE(PG8_SA(0, 1), a2 + hstep, voffA);
            PG8_WAIT_L(8); PG8_BAR; PG8_WAIT_L(0); PG8_MMA(0, 0, At, B0); PG8_BAR; PG8_SCHED;
            PG8_LDB(B1, 1, 1); PG8_STAGE(PG8_SB(1, 0), b3, voffB);
            PG8_BAR; PG8_WAIT_L(0); PG8_MMA(0, 1, At, B1); PG8_BAR;
            PG8_LDA(At, 1, 1); PG8_STAGE(PG8_SA(1, 0), a3, voffA);
            PG8_BAR; PG8_WAIT_L(0); PG8_MMA(1, 0, At, B0); PG8_BAR; PG8_SCHED;
            PG8_STAGE(PG8_SB(1, 1), b3 + hstep, voffB);
            PG8_WAIT_V(6); PG8_BAR; PG8_MMA(1, 1, At, B1); PG8_BAR;
            }
        }
        if constexpr (ALIGN_EPI) { if (wr == 0) PG8_BAR; }
        if constexpr (FP8) asm volatile("s_nop 15\n\ts_nop 15" ::: "memory");
        if constexpr (!Epi::AFTER_DRAIN) { E(acc, cur, wr, wc, fr, fq); S.done(cur); }
        if (!has_next) break;
#pragma unroll
        for (int a = 0; a < 2; ++a)
#pragma unroll
            for (int b = 0; b < 2; ++b)
#pragma unroll
                for (int m = 0; m < 4; ++m)
#pragma unroll
                    for (int n = 0; n < 2; ++n) acc[a][b][m][n] = (f32x4){0.f, 0.f, 0.f, 0.f};
        cur = nxt; cA = nA; cB = nB; ++ui;
        if constexpr (GATHER) {
#pragma unroll
            for (int h_ = 0; h_ < 2; ++h_) { gC[h_][0] = gN[h_][0]; gC[h_][1] = gN[h_][1]; } }
        if constexpr (ALIGN_EPI) { if (wr == 1) PG8_BAR; }
    }
    PG8_WAIT_V(0);
    if constexpr (!ALIGN_EPI) { if (wr == 0) PG8_BAR; }
    PG8_BAR;
    if constexpr (Epi::AFTER_DRAIN) { E.fused(acc, cur, wr, wc, fr, fq, lds, wid, lane); S.done(cur); }
#undef PG8_SA
#undef PG8_SB
#undef PG8_STAGE
#undef PG8_GLOAD
#undef PG8_GSETTLE
#undef PG8_STGA
#undef PG8_LDA
#undef PG8_LDB
#undef PG8_MMA
#undef PG8_LD8
#undef PG8_WAIT_V
#undef PG8_WAIT_L
#undef PG8_BAR
#undef PG8_SCHED
}
}

#define GAS __attribute__((address_space(1)))
#define LAS __attribute__((address_space(3)))
typedef unsigned short bf16;
typedef unsigned v4u __attribute__((ext_vector_type(4)));
typedef unsigned v2u __attribute__((ext_vector_type(2)));
typedef float f32x4 __attribute__((ext_vector_type(4)));
typedef float f32x2 __attribute__((ext_vector_type(2)));
typedef GAS unsigned gu32;
#define RLX_AGENT __ATOMIC_RELAXED, __HIP_MEMORY_SCOPE_AGENT
#define LDS_WAIT() asm volatile("s_waitcnt lgkmcnt(0)" ::: "memory")
#define VM_WAIT() asm volatile("s_waitcnt vmcnt(0)" ::: "memory")
__device__ __forceinline__ unsigned f2bf(float f) { unsigned u = __builtin_bit_cast(unsigned, f); return (u + 0x7fffu + ((u >> 16) & 1u)) >> 16; }
__device__ __forceinline__ unsigned pk2(float lo, float hi) { unsigned r; asm("v_cvt_pk_bf16_f32 %0, %1, %2" : "=v"(r) : "v"(lo), "v"(hi)); return r; }
__device__ __forceinline__ float bflo(unsigned w) { return __builtin_bit_cast(float, w << 16); }
__device__ __forceinline__ float bfhi(unsigned w) { return __builtin_bit_cast(float, w & 0xffff0000u); }
__device__ __forceinline__ unsigned pk4_fp8(float a, float b, float c, float d) {
    int w = __builtin_amdgcn_cvt_pk_fp8_f32(a, b, 0, false); w = __builtin_amdgcn_cvt_pk_fp8_f32(c, d, w, true); return (unsigned)w; }
__device__ __forceinline__ float wave_sum(float v) {
#define WS_DPP(x, ctrl, rm, bc) __builtin_bit_cast(float, __builtin_amdgcn_update_dpp(0, __builtin_bit_cast(int, (x)), (ctrl), (rm), 0xf, (bc)))
    v += WS_DPP(v, 0x111, 0xf, true); v += WS_DPP(v, 0x112, 0xf, true); v += WS_DPP(v, 0x114, 0xf, true); v += WS_DPP(v, 0x118, 0xf, true);
    v += WS_DPP(v, 0x142, 0xa, false);
    v += WS_DPP(v, 0x143, 0xc, false);
#undef WS_DPP
    return __builtin_bit_cast(float, __builtin_amdgcn_readlane(__builtin_bit_cast(int, v), 63));
}
__device__ __forceinline__ float sigmoidf_fast(float x) { return __builtin_amdgcn_rcpf(1.f + __builtin_amdgcn_exp2f(-1.4426950408889634f * x)); }

#define XB_TMO      128
#define XB_XCNT(j)  (256  + 64 * (j))
#define XB_XSUB(j)  (1280 + 64 * (j))
#define XB_XGEN(j)  (2304 + 64 * (j))
#define XB_TOP      3328
#define XB_TOPGEN   3392
#define XCD_BAR_WORDS 3456
#define XB_SPIN_CAP (1u << 18)

__device__ __forceinline__ unsigned xb_ld(unsigned* p)              { return __hip_atomic_load(p, __ATOMIC_RELAXED, __HIP_MEMORY_SCOPE_AGENT); }
__device__ __forceinline__ unsigned xb_add(unsigned* p, unsigned v) { return __hip_atomic_fetch_add(p, v, __ATOMIC_RELAXED, __HIP_MEMORY_SCOPE_AGENT); }
__device__ __forceinline__ unsigned xb_xcc_id() { return (unsigned)__builtin_amdgcn_s_getreg((3 << 11) | 20) & 0xFu; }
#define XB_SPIN(cond, bar) do { unsigned _sp = 0; while (cond) { __builtin_amdgcn_s_sleep(1); \
    if ((++_sp & 255u) == 0u) { if (xb_ld(&(bar)[XB_TMO])) break; if (_sp > XB_SPIN_CAP) { atomicAdd(&(bar)[XB_TMO], 1u); break; } } } } while (0)

struct XcdBarrier {
    unsigned* bar; unsigned x;
    volatile LAS unsigned* st;
};

__device__ __forceinline__ XcdBarrier xcd_barrier_post(unsigned* bar, volatile LAS unsigned* st) {
    XcdBarrier b; b.bar = bar; b.x = xb_xcc_id(); b.st = st;
    if (threadIdx.x == 0) (void)xb_add(&bar[XB_XCNT(b.x)], 1u);
    return b;
}
__device__ __forceinline__ void xcd_barrier_complete(unsigned* bar, unsigned x, unsigned& nloc, unsigned& nx) {
    const unsigned G = gridDim.x * gridDim.y * gridDim.z;
    unsigned sum, cnt, mine, sp = 0u;
    for (;;) {
        sum = 0u; cnt = 0u; mine = 0u;
#pragma unroll
        for (unsigned j = 0; j < 16; ++j) { const unsigned c = xb_ld(&bar[XB_XCNT(j)]); sum += c; cnt += (c > 0u) ? 1u : 0u; mine = (j == x) ? c : mine; }
        if (sum == G) break;
        __builtin_amdgcn_s_sleep(1);
        if ((++sp & 255u) == 0u) { if (xb_ld(&bar[XB_TMO])) break; if (sp > XB_SPIN_CAP) { atomicAdd(&bar[XB_TMO], 1u); break; } }
    }
    nloc = mine > 0u ? mine : 1u; nx = cnt > 0u ? cnt : 1u;
}

__device__ __forceinline__ void xcd_barrier(const XcdBarrier& b) {
    asm volatile("s_waitcnt vmcnt(0)" ::: "memory");
    __syncthreads();
    if (threadIdx.x == 0) {
        unsigned* bar = b.bar;
        __builtin_amdgcn_s_waitcnt(0);
        unsigned nloc = b.st[0], nx = b.st[1];
        if (nloc == 0u) { xcd_barrier_complete(bar, b.x, nloc, nx); b.st[0] = nloc; b.st[1] = nx; }
        const unsigned old = xb_add(&bar[XB_XSUB(b.x)], 1u);
        const unsigned gen = old / nloc;
        if (old + 1u == (gen + 1u) * nloc) {
            __builtin_amdgcn_fence(__ATOMIC_RELEASE, "agent");
            asm volatile("s_waitcnt vmcnt(0)" ::: "memory");
            const unsigned og = xb_add(&bar[XB_TOP], 1u);
            const unsigned tg = og / nx;
            if (og + 1u == (tg + 1u) * nx) xb_add(&bar[XB_TOPGEN], 1u);
            else XB_SPIN(xb_ld(&bar[XB_TOPGEN]) == tg, bar);
            __builtin_amdgcn_fence(__ATOMIC_ACQUIRE, "agent");
            xb_add(&bar[XB_XGEN(b.x)], 1u);
            asm volatile("s_waitcnt vmcnt(0)" ::: "memory");
        } else {
            XB_SPIN(xb_ld(&bar[XB_XGEN(b.x)]) == gen, bar);
            __builtin_amdgcn_fence(__ATOMIC_ACQUIRE, "agent");
            asm volatile("s_waitcnt vmcnt(0)" ::: "memory");
        }
    }
    __syncthreads();
}

constexpr int NWAVES = 8;
constexpr int S = 16384, D = 1024, NE = 32, FF = 1024;
constexpr int NIN = 9296, NPROJ8 = 8192, NPROJ16 = 1280;
constexpr float WIN_FP8_SCALE = 32.f;
constexpr float O2_FP8_SCALE = 64.f;
constexpr float Y_FP8_SCALE = 8.f, WAB_FP8_SCALE = 32.f, MG_FP8_SCALE = 8.f, WO_FP8_SCALE = 64.f;
constexpr float LN_EPS = 1e-5f;
constexpr float ALPHA = 1.18920711500272f;
constexpr float LOG2E = 1.4426950408889634f;
constexpr float QA_SCALE = 0.125f * LOG2E;
constexpr float QB_SCALE = 0.08838834764831845f * LOG2E;
constexpr float WI_SCALE = 0.125f * 0.25f;
constexpr float LAM_INIT = 0.2f;
constexpr float W1_FP8_SCALE = 32.f, W2_FP8_SCALE = 64.f;

constexpr size_t MiB = 1u << 20;
constexpr size_t WS_CTL = 0, CTL_ZERO_BYTES = 1 * MiB;
constexpr size_t WS_SMALL = 1 * MiB;
constexpr size_t WS_WIN = 2 * MiB;
constexpr size_t WS_WIN8 = 6 * MiB;
constexpr size_t WS_WA = 21 * MiB, WS_WB = 23 * MiB, WS_WO = 25 * MiB;
constexpr size_t WS_W1 = 27 * MiB;
constexpr size_t WS_W2 = 155 * MiB;
constexpr size_t WS_X1 = 219 * MiB;
constexpr size_t WS_IDXTOK = WS_X1;
constexpr size_t WS_IDXW = WS_X1 + 4 * MiB;
constexpr size_t WS_Y1 = 283 * MiB;
constexpr size_t WS_VB16 = 347 * MiB;
constexpr size_t WS_TOKE = 379 * MiB;
constexpr size_t WS_TOKP = WS_TOKE + 256 * 1024;
constexpr size_t WS_TOKW = WS_TOKP + 256 * 1024;
constexpr size_t WS_TOKSLOT = WS_TOKW + 256 * 1024;
constexpr size_t WS_SLOTW = WS_TOKSLOT + 256 * 1024;
constexpr size_t WS_NSD = WS_SLOTW + 320 * 1024;
constexpr size_t WS_ERA = 381 * MiB;
constexpr size_t WS_U = WS_ERA;
constexpr size_t WS_PROJ = WS_ERA + 32 * MiB;
constexpr size_t PROJ_STRIDE = (size_t)S * D;
constexpr size_t WS_KI = WS_ERA + 320 * MiB;
constexpr size_t WS_WI = WS_ERA + 322 * MiB;
constexpr size_t WS_MASK = WS_ERA + 323 * MiB;
constexpr size_t WS_YA = WS_ERA + 355 * MiB, WS_YB = WS_ERA + 387 * MiB;
constexpr size_t WS_SCR = WS_ERA + 419 * MiB;
constexpr size_t WS_T1 = WS_ERA + 451 * MiB;
constexpr size_t WS_MG = WS_ERA + 515 * MiB;
constexpr int MAXSLOT = 73728;
constexpr size_t WS_XS = WS_ERA;
constexpr size_t WS_H = WS_ERA + 144 * MiB;
constexpr size_t WS_OUT2 = WS_ERA + 288 * MiB;
constexpr size_t WS_U8 = WS_ERA + 547 * MiB;
constexpr size_t WS_END = WS_ERA + 563 * MiB;
static_assert(WS_END <= 1024 * MiB, "workspace map");

constexpr int CW_BAR = 4096;
constexpr int CW_NRM = 9216;
constexpr int CW_BG = 9472, CW_DONE = 9536;
constexpr int CW_P0 = 9600;
constexpr int CW_Q3 = 8192, CW_Q4D = 8448, CW_Q4S = 8704, CW_ECNT = 8960;

constexpr int RING_OFF = 0, RING_BYTES = 131072;
constexpr int LDSCTL_OFF = 145408;
constexpr int MISC_OFF = LDSCTL_OFF + 320;
constexpr int L_CNT = LDSCTL_OFF + 1024;
constexpr int L_BASE = L_CNT + 128;
constexpr int L_OFF = L_BASE + 128;
constexpr int L_TEXP = L_OFF + 256;
constexpr int L_NT = L_TEXP + 320;
constexpr int L_QI = L_NT + 16;
constexpr int L_TINFO = L_QI + 16;
constexpr int L_ORDER = L_TINFO + 64 * 4 * 12;
constexpr int L_T0 = L_ORDER + 4096;
constexpr int LDS_BYTES = 161792;
static_assert(L_T0 + 2048 <= LDS_BYTES, "LDS map");

struct Args { const float* in[23]; float* out; unsigned char* ws; int ph_lo, ph_hi; };
typedef const __attribute__((address_space(4))) Args* KArgs;
__device__ __forceinline__ KArgs kargs() { KArgs p = (KArgs)__builtin_amdgcn_kernarg_segment_ptr(); asm volatile("" : "+s"(p)); return p; }
struct Frame {
    LAS unsigned char* lds;
    volatile LAS unsigned* MISC;
    gu32* ctl;
    int tid, lane, wave, G, bid;
    unsigned char* ws;
    KArgs ap;
};
#define FIN(F, k) ((F).ap->in[k])

namespace epi {
using pg8::Unit; using pg8::cvt_pk_bf16; using pg8::bf16_t; using pg8::HALF; using pg8::BM;
typedef pg8::f32x4 f4; typedef pg8::u32x4 u4; typedef unsigned u2 __attribute__((ext_vector_type(2)));

struct EpiProj8 {
    static constexpr bool PERM = true, AFTER_DRAIN = false;
    bf16_t* out;
    __device__ __forceinline__ void operator()(const f4 (&acc)[2][2][4][2], const Unit& u, int wr, int wc, int fr, int fq) const {
        const int row0 = u.pm * BM + wr * 64 + fr;
        const int tile = u.pn;
        const int buf = tile < 24 ? (tile >> 2) : 7 + ((tile - 24) >> 2);
        bf16_t* base = out + (size_t)buf * PROJ_STRIDE;
        const int col0 = (tile & 3) * 256 + wc * 32 + 8 * fq;
        const float sc = (1.f / WIN_FP8_SCALE) * ((buf == 0) ? QA_SCALE : ((buf == 3) ? QB_SCALE : 1.f));
        const bool sig = buf >= 7;
#pragma unroll
        for (int ai = 0; ai < 2; ++ai)
#pragma unroll
            for (int m = 0; m < 4; ++m) { bf16_t* rowp = base + (size_t)(row0 + ai * HALF + m * 16) * D + col0;
#pragma unroll
                for (int bj = 0; bj < 2; ++bj) { f4 v0 = acc[ai][bj][m][0] * sc, v1 = acc[ai][bj][m][1] * sc;
                    if (sig) {
#pragma unroll
                        for (int e = 0; e < 4; ++e) { v0[e] = sigmoidf_fast(v0[e]); v1[e] = sigmoidf_fast(v1[e]); }
                    }
                    u4 w; w.x = cvt_pk_bf16(v0[0], v0[1]); w.y = cvt_pk_bf16(v0[2], v0[3]); w.z = cvt_pk_bf16(v1[0], v1[1]); w.w = cvt_pk_bf16(v1[2], v1[3]);
                    *(u4*)(rowp + bj * HALF) = w; } }
    }
};
struct EpiProjIdx {
    static constexpr bool PERM = true, AFTER_DRAIN = false;
    bf16_t* qi; bf16_t* ki; float* wi;
    __device__ __forceinline__ void operator()(const f4 (&acc)[2][2][4][2], const Unit& u, int wr, int wc, int fr, int fq) const {
        const int row0 = u.pm * BM + wr * 64 + fr;
        const int tile = u.pn;
        if (tile < 4) {
            const int col0 = tile * 256 + wc * 32 + 8 * fq;
#pragma unroll
            for (int ai = 0; ai < 2; ++ai)
#pragma unroll
                for (int m = 0; m < 4; ++m) { bf16_t* rowp = qi + (size_t)(row0 + ai * HALF + m * 16) * D + col0;
#pragma unroll
                    for (int bj = 0; bj < 2; ++bj) { const f4 v0 = acc[ai][bj][m][0], v1 = acc[ai][bj][m][1];
                        u4 w; w.x = cvt_pk_bf16(v0[0], v0[1]); w.y = cvt_pk_bf16(v0[2], v0[3]); w.z = cvt_pk_bf16(v1[0], v1[1]); w.w = cvt_pk_bf16(v1[2], v1[3]);
                        *(u4*)(rowp + bj * HALF) = w; } }
        } else {
            const int c0 = wc * 32 + 8 * fq;
            if (wc < 2) {
#pragma unroll
                for (int ai = 0; ai < 2; ++ai)
#pragma unroll
                    for (int m = 0; m < 4; ++m) { const f4 v0 = acc[ai][0][m][0], v1 = acc[ai][0][m][1];
                        u4 w; w.x = cvt_pk_bf16(v0[0], v0[1]); w.y = cvt_pk_bf16(v0[2], v0[3]); w.z = cvt_pk_bf16(v1[0], v1[1]); w.w = cvt_pk_bf16(v1[2], v1[3]);
                        *(u4*)(ki + (size_t)(row0 + ai * HALF + m * 16) * 64 + c0) = w; }
            } else if (wc == 2 && fq < 2) {
#pragma unroll
                for (int ai = 0; ai < 2; ++ai)
#pragma unroll
                    for (int m = 0; m < 4; ++m) { float* p = wi + (size_t)(row0 + ai * HALF + m * 16) * 16 + (c0 - 64);
                        *(f4*)p = acc[ai][0][m][0] * WI_SCALE; *(f4*)(p + 4) = acc[ai][0][m][1] * WI_SCALE; }
            }
        }
    }
};

struct EpiGateA {
    static constexpr bool PERM = false, AFTER_DRAIN = false;
    const bf16_t* gate; float* t1;
    __device__ __forceinline__ void operator()(const f4 (&acc)[2][2][4][2], const Unit& u, int wr, int wc, int fr, int fq) const {
        const int col0 = u.pn * BM + wc * 32 + 4 * fq;
#pragma unroll
        for (int ai = 0; ai < 2; ++ai)
#pragma unroll
            for (int m = 0; m < 4; ++m) { const size_t off = (size_t)(u.pm * BM + ai * HALF + wr * 64 + m * 16 + fr) * D + col0;
#pragma unroll
                for (int bj = 0; bj < 2; ++bj)
#pragma unroll
                    for (int n = 0; n < 2; ++n) { const size_t o = off + bj * HALF + n * 16; const u2 g = *(const u2*)(gate + o);
                        f4 v = acc[ai][bj][m][n] * (1.f / (Y_FP8_SCALE * WAB_FP8_SCALE)); v[0] *= bflo(g.x); v[1] *= bfhi(g.x); v[2] *= bflo(g.y); v[3] *= bfhi(g.y);
                        *(f4*)(t1 + o) = v; } }
    }
};
struct EpiGateB {
    static constexpr bool PERM = false, AFTER_DRAIN = false;
    const bf16_t* gate; const float* t1; unsigned char* mg;
    __device__ __forceinline__ void operator()(const f4 (&acc)[2][2][4][2], const Unit& u, int wr, int wc, int fr, int fq) const {
        const int col0 = u.pn * BM + wc * 32 + 4 * fq;
#pragma unroll
        for (int ai = 0; ai < 2; ++ai)
#pragma unroll
            for (int m = 0; m < 4; ++m) { const size_t off = (size_t)(u.pm * BM + ai * HALF + wr * 64 + m * 16 + fr) * D + col0;
#pragma unroll
                for (int bj = 0; bj < 2; ++bj)
#pragma unroll
                    for (int n = 0; n < 2; ++n) { const size_t o = off + bj * HALF + n * 16; const u2 g = *(const u2*)(gate + o); const f4 t = *(const f4*)(t1 + o);
                        f4 v = acc[ai][bj][m][n] * (1.f / (Y_FP8_SCALE * WAB_FP8_SCALE)); v[0] = t[0] + v[0] * bflo(g.x); v[1] = t[1] + v[1] * bfhi(g.x); v[2] = t[2] + v[2] * bflo(g.y); v[3] = t[3] + v[3] * bfhi(g.y);
                        v = v * MG_FP8_SCALE; *(unsigned*)(mg + o) = pk4_fp8(v[0], v[1], v[2], v[3]); } }
    }
};
struct EpiOut {
    static constexpr bool PERM = false, AFTER_DRAIN = false;
    const float* x; const float* ga; bf16_t* y1;
    __device__ __forceinline__ void operator()(const f4 (&acc)[2][2][4][2], const Unit& u, int wr, int wc, int fr, int fq) const {
        const int col0 = u.pn * BM + wc * 32 + 4 * fq;
        f4 gv[2][2];
#pragma unroll
        for (int bj = 0; bj < 2; ++bj)
#pragma unroll
            for (int n = 0; n < 2; ++n) gv[bj][n] = *(const f4*)(ga + col0 + bj * HALF + n * 16);
#pragma unroll
        for (int ai = 0; ai < 2; ++ai)
#pragma unroll
            for (int m = 0; m < 4; ++m) { const size_t off = (size_t)(u.pm * BM + ai * HALF + wr * 64 + m * 16 + fr) * D + col0;
#pragma unroll
                for (int bj = 0; bj < 2; ++bj)
#pragma unroll
                    for (int n = 0; n < 2; ++n) { const size_t o = off + bj * HALF + n * 16; const f4 xv = *(const f4*)(x + o);
                        const f4 yv = xv * ALPHA + gv[bj][n] * (acc[ai][bj][m][n] * (1.f / (MG_FP8_SCALE * WO_FP8_SCALE)));
                        u2 w; w.x = cvt_pk_bf16(yv[0], yv[1]); w.y = cvt_pk_bf16(yv[2], yv[3]); *(u2*)(y1 + o) = w; } }
    }
};
struct EpiMoe1 {
    static constexpr bool PERM = true, AFTER_DRAIN = false;
    const float* b1; unsigned char* h;
    __device__ __forceinline__ void operator()(const f4 (&acc)[2][2][4][2], const Unit& u, int wr, int wc, int fr, int fq) const {
        const int e = u.pn >> 3, pnl = u.pn & 7;
        const int row0 = u.pm * BM + wr * 64 + fr;
        const int c0 = pnl * 256 + wc * 32 + 8 * fq;
        f4 bv[2][2];
#pragma unroll
        for (int bj = 0; bj < 2; ++bj)
#pragma unroll
            for (int n = 0; n < 2; ++n) bv[bj][n] = *(const f4*)(b1 + (size_t)e * 2048 + c0 + bj * HALF + 4 * n);
#pragma unroll
        for (int ai = 0; ai < 2; ++ai)
#pragma unroll
            for (int m = 0; m < 4; ++m) { unsigned char* rowp = h + (size_t)(row0 + ai * HALF + m * 16) * FF + (c0 >> 1);
#pragma unroll
                for (int bj = 0; bj < 2; ++bj) { const f4 v0 = acc[ai][bj][m][0] * (1.f / W1_FP8_SCALE) + bv[bj][0], v1 = acc[ai][bj][m][1] * (1.f / W1_FP8_SCALE) + bv[bj][1];
                    float a[4];
#pragma unroll
                    for (int p = 0; p < 4; ++p) { const float g = (p < 2) ? v0[2 * p] : v1[2 * p - 4], l = (p < 2) ? v0[2 * p + 1] : v1[2 * p - 3];
                        const float gl = fminf(g, 7.f), ll = fminf(fmaxf(l, -7.f), 7.f);
                        a[p] = gl * sigmoidf_fast(1.702f * gl) * (ll + 1.f); }
                    *(unsigned*)(rowp + bj * (HALF / 2)) = pk4_fp8(a[0], a[1], a[2], a[3]); } }
    }
};
struct EpiMoe2 {
    static constexpr bool PERM = true, AFTER_DRAIN = false;
    const float* b2; const float* idxw; const LAS unsigned* off; unsigned char* o2;
    __device__ __forceinline__ void operator()(const f4 (&acc)[2][2][4][2], const Unit& u, int wr, int wc, int fr, int fq) const {
        const int e = u.pn >> 2, pnl = u.pn & 3;
        const int row0 = u.pm * BM + wr * 64 + fr;
        const int c0 = pnl * 256 + wc * 32 + 8 * fq;
        f4 bv[2][2];
#pragma unroll
        for (int bj = 0; bj < 2; ++bj)
#pragma unroll
            for (int n = 0; n < 2; ++n) bv[bj][n] = *(const f4*)(b2 + (size_t)e * D + c0 + bj * HALF + 4 * n);
#pragma unroll
        for (int ai = 0; ai < 2; ++ai)
#pragma unroll
            for (int m = 0; m < 4; ++m) { const int row = row0 + ai * HALF + m * 16; const float gw = idxw[(size_t)e * S + (row - (int)off[e])] * O2_FP8_SCALE; unsigned char* rowp = o2 + (size_t)row * D + c0;
#pragma unroll
                for (int bj = 0; bj < 2; ++bj) { const f4 v0 = (acc[ai][bj][m][0] * (1.f / W2_FP8_SCALE) + bv[bj][0]) * gw, v1 = (acc[ai][bj][m][1] * (1.f / W2_FP8_SCALE) + bv[bj][1]) * gw;
                    u2 w; w.x = pk4_fp8(v0[0], v0[1], v0[2], v0[3]); w.y = pk4_fp8(v1[0], v1[1], v1[2], v1[3]);
                    *(u2*)(rowp + bj * HALF) = w; } }
    }
};
struct MoeOrder {
    const LAS unsigned char* texp; int ntiles, nN, G, c;
    const int* idxtok; const LAS unsigned* off; const LAS unsigned* cnt;
    __device__ __forceinline__ const int* row_ptr(const Unit& u, int r) const { const int e = (int)texp[u.pm]; const int p = (u.pm << 8) - (int)off[e] + r, c1 = (int)cnt[e] - 1; return idxtok + (size_t)e * S + (p < c1 ? p : c1); }
    __device__ __forceinline__ bool next(int i, Unit& u) const {
        const long L = (long)i * G + c; if (L >= (long)ntiles * nN) return false;
        const int pm = (int)(L / nN), pnl = (int)(L % nN);
        u.pm = pm; u.pn = (int)texp[pm] * nN + pnl; return true;
    }
    __device__ __forceinline__ void a_ready(const Unit&) const {}
    __device__ __forceinline__ void done(const Unit&) const {}
};
struct ProjOrder {
    pg8::StaticOrder s;
    __device__ __forceinline__ int count() const { return s.c < 64 ? 6 : s.c < 192 ? 9 : 8; }
    __device__ __forceinline__ bool next(int i, Unit& u) const {
        if (i < 6) return s.at((long)i * 256 + s.c, u);
        const int j = i - 6, x = s.c - 64;
        if (x < 0) return false;
        if (j < 2) return s.at(1536 + 192 * j + x, u);
        if (j == 2 && x < 128) return s.at(1920 + x, u);
        return false;
    }
    __device__ __forceinline__ void a_ready(const Unit&) const {}
    __device__ __forceinline__ void done(const Unit&) const {}
};
template <class Sd> struct RepOrder {
    Sd s; int n, reps;
    __device__ __forceinline__ bool next(int i, Unit& u) const { if (i >= n * reps) return false; return s.next(reps == 1 ? i : i % n, u); }
    __device__ __forceinline__ const int* row_ptr(const Unit& u, int r) const { return s.row_ptr(u, r); }
    __device__ __forceinline__ void a_ready(const Unit&) const {}
    __device__ __forceinline__ void done(const Unit&) const {}
};
}

namespace att {
using bf16x8 = __attribute__((ext_vector_type(8))) short;
using s16x4  = __attribute__((ext_vector_type(4))) short;
using f32x16 = __attribute__((ext_vector_type(16))) float;
using u32x4  = __attribute__((ext_vector_type(4))) unsigned;
constexpr int NW = 8, QBLK = 32, KVBLK = 64;
constexpr int SHM_V = 16384, SHM_K = 16384;
constexpr int L_V = 0, L_K = 2 * SHM_V, L_WS = 2 * SHM_V + 2 * SHM_K;
constexpr float THRL = 11.5f;
constexpr int KPF_DIFF = 2, KPF_DSA = 1;
constexpr int SDEPTH_DIFF = 2, SDEPTH_DSA = 1;
#define ASBAR() __builtin_amdgcn_sched_barrier(0)
__device__ __forceinline__ int crow(int r, int hi) { return (r & 3) + 8 * (r >> 2) + 4 * hi; }
__device__ __forceinline__ unsigned cvtpk(float lo, float hi) { unsigned r; asm volatile("v_cvt_pk_bf16_f32 %0, %1, %2" : "=v"(r) : "v"(lo), "v"(hi)); return r; }
template <int DQK> __device__ __forceinline__ int kswz(int row, int colB) {
    if constexpr (DQK == 128) return row * 256 + (colB ^ ((row & 7) << 4));
    else return row * 128 + (colB ^ (((row >> 1) & 7) << 4));
}
template <int DQK> __device__ __forceinline__ void qkt(f32x16& p0, f32x16& p1, const char* Ks, const bf16x8* qr, int r32, int hi) {
    p0 = f32x16{}; p1 = f32x16{};
#pragma unroll
    for (int d0 = 0; d0 < DQK / 16; ++d0) { const int cb = (d0 * 16 + hi * 8) * 2;
        const bf16x8 b0 = *reinterpret_cast<const bf16x8*>(Ks + kswz<DQK>(r32, cb));
        const bf16x8 b1 = *reinterpret_cast<const bf16x8*>(Ks + kswz<DQK>(32 + r32, cb));
        p0 = __builtin_amdgcn_mfma_f32_32x32x16_bf16(b0, qr[d0], p0, 0, 0, 0);
        p1 = __builtin_amdgcn_mfma_f32_32x32x16_bf16(b1, qr[d0], p1, 0, 0, 0); }
}
template <bool DSA> __device__ __forceinline__ void fixup_old(f32x16& p0, f32x16& p1, float qrel, float nslope, bool vis, unsigned mlo, unsigned mhi) {
    const float NEG = -__builtin_inff();
#pragma unroll
    for (int r = 0; r < 16; ++r) {
        const int bit = (r & 3) + 8 * (r >> 2);
        const float d0 = qrel - (float)bit, d1 = d0 - 32.f;
        const float s0 = __builtin_fmaf(__builtin_fabsf(d0), nslope, p0[r]);
        const float s1 = __builtin_fmaf(__builtin_fabsf(d1), nslope, p1[r]);
        bool k0 = vis, k1 = vis;
        if constexpr (DSA) { k0 = k0 && ((mlo >> bit) & 1u); k1 = k1 && ((mhi >> bit) & 1u); }
        p0[r] = k0 ? s0 : NEG; p1[r] = k1 ? s1 : NEG;
    }
}
__device__ __forceinline__ void partialSM_old(f32x16& p0, f32x16& p1, float& m_reg, float& mn, float& alpha) {
    float pmax = p0[0];
#pragma unroll
    for (int r = 1; r < 16; ++r) pmax = fmaxf(pmax, p0[r]);
#pragma unroll
    for (int r = 0; r < 16; ++r) pmax = fmaxf(pmax, p1[r]);
    { auto rr = __builtin_amdgcn_permlane32_swap(__float_as_uint(pmax), __float_as_uint(pmax), false, false);
      pmax = fmaxf(__uint_as_float(rr[0]), __uint_as_float(rr[1])); }
    if (__builtin_expect(__all(pmax - m_reg <= THRL), 1)) { mn = m_reg; alpha = 1.f; }
    else { mn = fmaxf(m_reg, pmax); alpha = __builtin_amdgcn_exp2f(m_reg - mn); m_reg = mn; }
#pragma unroll
    for (int r = 0; r < 16; ++r) { p0[r] = p0[r] - mn; p1[r] = p1[r] - mn; }
#pragma unroll
    for (int r = 0; r < 16; ++r) p0[r] = __builtin_amdgcn_exp2f(p0[r]);
}
template <bool DSA> __device__ __forceinline__ float msel(float v, unsigned mw, int bit) {
    if constexpr (DSA) { const unsigned m = (unsigned)__builtin_amdgcn_sbfe((int)mw, bit, 1); return __uint_as_float((__float_as_uint(v) & m) | (0xff800000u & ~m)); }
    else return v;
}
template <bool DSA> __device__ __forceinline__ void fix_fast(f32x16& p0, f32x16& p1, float sl, unsigned mlo, unsigned mhi) {
#pragma unroll
    for (int r = 0; r < 16; ++r) {
        const int bit = (r & 3) + 8 * (r >> 2);
        p0[r] = msel<DSA>(__builtin_fmaf(sl, (float)bit, p0[r]), mlo, bit);
        p1[r] = msel<DSA>(__builtin_fmaf(sl, (float)(bit + 32), p1[r]), mhi, bit);
    }
}
template <bool DSA> __device__ __forceinline__ void fix_slow(f32x16& p0, f32x16& p1, float qrel, float sl, bool vis, unsigned mlo, unsigned mhi) {
    const float NEG = -__builtin_inff();
#pragma unroll
    for (int r = 0; r < 16; ++r) {
        const int bit = (r & 3) + 8 * (r >> 2);
        const float d0 = qrel - (float)bit, d1 = d0 - 32.f;
        const float s0 = __builtin_fmaf(sl, qrel - __builtin_fabsf(d0), p0[r]);
        const float s1 = __builtin_fmaf(sl, qrel - __builtin_fabsf(d1), p1[r]);
        p0[r] = vis ? msel<DSA>(s0, mlo, bit) : NEG; p1[r] = vis ? msel<DSA>(s1, mhi, bit) : NEG;
    }
}
__device__ __forceinline__ void partialSM(f32x16& p0, f32x16& p1, float& m_reg, float& mn, float& alpha, float chi, float tau) {
    const float mloc = m_reg - tau;
    float pmax = p0[0];
#pragma unroll
    for (int r = 1; r < 16; ++r) pmax = fmaxf(pmax, p0[r]);
#pragma unroll
    for (int r = 0; r < 16; ++r) pmax = fmaxf(pmax, p1[r]);
    pmax += chi;
    { auto rr = __builtin_amdgcn_permlane32_swap(__float_as_uint(pmax), __float_as_uint(pmax), false, false);
      pmax = fmaxf(__uint_as_float(rr[0]), __uint_as_float(rr[1])); }
    pmax -= chi;
    if (__builtin_expect(__all(pmax - mloc <= THRL), 1)) { mn = mloc; alpha = 1.f; }
    else { mn = fmaxf(mloc, pmax); alpha = __builtin_amdgcn_exp2f(mloc - mn); }
    m_reg = mn + tau;
#pragma unroll
    for (int r = 0; r < 16; ++r) { p0[r] = p0[r] - mn; p1[r] = p1[r] - mn; }
#pragma unroll
    for (int r = 0; r < 16; ++r) p0[r] = __builtin_amdgcn_exp2f(p0[r]);
}
__device__ __forceinline__ void fixedSM(f32x16& p0, f32x16& p1, float mref) {
#pragma unroll
    for (int r = 0; r < 16; ++r) { p0[r] = p0[r] - mref; p1[r] = p1[r] - mref; }
#pragma unroll
    for (int r = 0; r < 16; ++r) p0[r] = __builtin_amdgcn_exp2f(p0[r]);
}
__device__ __forceinline__ void finishSM(f32x16& p0, f32x16& p1, float alpha, float& l_reg, bf16x8& pa0, bf16x8& pa1, bf16x8& pa2, bf16x8& pa3) {
#pragma unroll
    for (int r = 0; r < 16; ++r) p1[r] = __builtin_amdgcn_exp2f(p1[r]);
    float ps = 0;
#pragma unroll
    for (int r = 0; r < 16; ++r) ps += p0[r];
#pragma unroll
    for (int r = 0; r < 16; ++r) ps += p1[r];
    { auto rr = __builtin_amdgcn_permlane32_swap(__float_as_uint(ps), __float_as_uint(ps), false, false);
      ps = __uint_as_float(rr[0]) + __uint_as_float(rr[1]); }
    l_reg = l_reg * alpha + ps;
#define ATT_PK4(P, BASE, OUT) do { unsigned a0 = cvtpk(P[BASE + 0], P[BASE + 1]), a1 = cvtpk(P[BASE + 2], P[BASE + 3]);   \
    unsigned b0 = cvtpk(P[BASE + 4], P[BASE + 5]), b1 = cvtpk(P[BASE + 6], P[BASE + 7]);                              \
    auto r0 = __builtin_amdgcn_permlane32_swap(a0, b0, false, false); auto r1 = __builtin_amdgcn_permlane32_swap(a1, b1, false, false); \
    u32x4 w = {r0[0], r1[0], r0[1], r1[1]}; OUT = *reinterpret_cast<bf16x8*>(&w); } while (0)
    ATT_PK4(p0, 0, pa0); ATT_PK4(p0, 8, pa1); ATT_PK4(p1, 0, pa2); ATT_PK4(p1, 8, pa3);
#undef ATT_PK4
}
__device__ __forceinline__ int v_st(int k, int c) { const int kk = (k & ~0xC) | ((k & 4) << 1) | ((k & 8) >> 1); return ((kk >> 3) * 4 + (c >> 5)) * 512 + ((kk & 7) * 32 + (c & 31)) * 2; }
__device__ __forceinline__ int v_rd_base(int lane) { return ((lane & 3) << 3) | (((lane >> 2) & 3) << 6) | (((lane >> 4) & 1) << 5) | (((lane >> 5) & 1) << 8); }
constexpr int v_rd_off(int d0, int ks, int half) { return d0 * 512 + ks * 4096 + half * 2048; }
template <int OFF> __device__ __forceinline__ s16x4 tr_read(int vb) {
    s16x4 r; asm volatile("ds_read_b64_tr_b16 %0, %1 offset:%2" : "=&v"(r) : "v"(vb), "i"(OFF) : "memory"); return r;
}
template <int D0> __device__ __forceinline__ void pv_one(f32x16& od, int vb, bf16x8 pa0, bf16x8 pa1, bf16x8 pa2, bf16x8 pa3) {
    const s16x4 l0 = tr_read<v_rd_off(D0, 0, 0)>(vb), h0 = tr_read<v_rd_off(D0, 0, 1)>(vb), l1 = tr_read<v_rd_off(D0, 1, 0)>(vb), h1 = tr_read<v_rd_off(D0, 1, 1)>(vb);
    const s16x4 l2 = tr_read<v_rd_off(D0, 2, 0)>(vb), h2 = tr_read<v_rd_off(D0, 2, 1)>(vb), l3 = tr_read<v_rd_off(D0, 3, 0)>(vb), h3 = tr_read<v_rd_off(D0, 3, 1)>(vb);
    asm volatile("s_waitcnt lgkmcnt(0)" ::: "memory"); ASBAR();
#define ATT_PK(L, H) (bf16x8){L[0], L[1], L[2], L[3], H[0], H[1], H[2], H[3]}
    od = __builtin_amdgcn_mfma_f32_32x32x16_bf16(pa0, ATT_PK(l0, h0), od, 0, 0, 0);
    od = __builtin_amdgcn_mfma_f32_32x32x16_bf16(pa1, ATT_PK(l1, h1), od, 0, 0, 0);
    od = __builtin_amdgcn_mfma_f32_32x32x16_bf16(pa2, ATT_PK(l2, h2), od, 0, 0, 0);
    od = __builtin_amdgcn_mfma_f32_32x32x16_bf16(pa3, ATT_PK(l3, h3), od, 0, 0, 0);
#undef ATT_PK
}
__device__ __forceinline__ void pv_d0(f32x16* o, int vb, bf16x8 pa0, bf16x8 pa1, bf16x8 pa2, bf16x8 pa3) {
    pv_one<0>(o[0], vb, pa0, pa1, pa2, pa3); pv_one<1>(o[1], vb, pa0, pa1, pa2, pa3); pv_one<2>(o[2], vb, pa0, pa1, pa2, pa3); pv_one<3>(o[3], vb, pa0, pa1, pa2, pa3);
}

template <int DQK, bool DSA> __device__ __forceinline__ void qkt_init(f32x16& p0, f32x16& p1, const char* Ks, const bf16x8* qr, int r32, int hi, float cin, unsigned mlo, unsigned mhi) {
#pragma unroll
    for (int r = 0; r < 16; ++r) {
        if constexpr (DSA) { const int bit = (r & 3) + 8 * (r >> 2);
            const unsigned m0 = (unsigned)__builtin_amdgcn_sbfe((int)mlo, bit, 1), m1 = (unsigned)__builtin_amdgcn_sbfe((int)mhi, bit, 1);
            p0[r] = __uint_as_float((__float_as_uint(cin) & m0) | (0xff800000u & ~m0)); p1[r] = __uint_as_float((__float_as_uint(cin) & m1) | (0xff800000u & ~m1)); }
        else { p0[r] = cin; p1[r] = cin; }
    }
    bf16x8 zq; { int zz = 0; asm volatile("" : "+v"(zz)); zq = (bf16x8){(short)zz, (short)zz, (short)zz, (short)zz, (short)zz, (short)zz, (short)zz, (short)zz}; } (void)zq;
#pragma unroll
    for (int d0 = 0; d0 < DQK / 16; ++d0) { const int cb = (d0 * 16 + hi * 8) * 2;
        const bf16x8 b0 = *reinterpret_cast<const bf16x8*>(Ks + kswz<DQK>(r32, cb));
        const bf16x8 b1 = *reinterpret_cast<const bf16x8*>(Ks + kswz<DQK>(32 + r32, cb));
        p0 = __builtin_amdgcn_mfma_f32_32x32x16_bf16(b0, qr[d0], p0, 0, 0, 0);
        p1 = __builtin_amdgcn_mfma_f32_32x32x16_bf16(b1, qr[d0], p1, 0, 0, 0);
        if constexpr (PROBE_DUP == 43) {
            p0 = __builtin_amdgcn_mfma_f32_32x32x16_bf16(b0, zq, p0, 0, 0, 0); p1 = __builtin_amdgcn_mfma_f32_32x32x16_bf16(b1, zq, p1, 0, 0, 0); } }
    if constexpr (PROBE_DUP != 43) {
        constexpr int KPF = DSA ? KPF_DSA : KPF_DIFF, N = DQK / 16;
        if constexpr (KPF > 0) {
            __builtin_amdgcn_sched_group_barrier(0x100, 2 * KPF, 0);
#pragma unroll
            for (int d0 = 0; d0 < N - KPF; ++d0) { __builtin_amdgcn_sched_group_barrier(0x100, 2, 0); __builtin_amdgcn_sched_group_barrier(0x008, 2, 0); }
            __builtin_amdgcn_sched_group_barrier(0x008, 2 * KPF, 0);
        }
    }
}
__device__ __forceinline__ void bias_exp(f32x16& p0, f32x16& p1, float sl, bool band, float qrel) {
#pragma unroll
    for (int r = 0; r < 16; ++r) { const int bit = (r & 3) + 8 * (r >> 2);
        p0[r] = __builtin_fmaf(sl, (float)bit, p0[r]); p1[r] = __builtin_fmaf(sl, (float)(bit + 32), p1[r]); }
    if constexpr (PROBE_DUP == 44) {
        float z = 0.f; asm volatile("" : "+v"(z));
#pragma unroll
        for (int r = 0; r < 16; ++r) { const int bit = (r & 3) + 8 * (r >> 2);
            p0[r] = __builtin_fmaf(z, (float)bit, p0[r]); p1[r] = __builtin_fmaf(z, (float)(bit + 32), p1[r]); } }
    if (band) { const float sl2 = 2.f * sl;
#pragma unroll
        for (int r = 0; r < 16; ++r) { const int bit = (r & 3) + 8 * (r >> 2);
            const float d0 = qrel - (float)bit, d1 = d0 - 32.f;
            p0[r] = __builtin_fmaf(sl2, fminf(d0, 0.f), p0[r]); p1[r] = __builtin_fmaf(sl2, fminf(d1, 0.f), p1[r]); } }
#pragma unroll
    for (int r = 0; r < 16; ++r) p0[r] = __builtin_amdgcn_exp2f(p0[r]);
}

template <int DQK, bool DSA>
__device__ __forceinline__ void attn_body(const bf16* __restrict__ Qb, const bf16* __restrict__ Kh, const bf16* __restrict__ Vh, int NT, int tmaxw, int qpos0, int kshift, float nslope, float kmax2, const unsigned* __restrict__ nsd,
                                          const unsigned long long* __restrict__ mask, f32x16 (&o)[4], float (&rli)[16], char* lds) {
    int tid_ = threadIdx.x; asm volatile("" : "+v"(tid_));
    constexpr int SDEPTH = DSA ? SDEPTH_DSA : SDEPTH_DIFF;
    const int tid = tid_, wid = __builtin_amdgcn_readfirstlane(tid >> 6), lane = tid & 63, r32 = lane & 31, hi = lane >> 5;
    char* V_lds = lds + L_V; char* K_lds = lds + L_K;
    float* ws = (float*)(lds + L_WS) + wid * 64; float* li_l = ws;
    float l_reg = 0.f;
#pragma unroll
    for (int d = 0; d < 4; ++d) o[d] = f32x16{};
    bf16x8 qr[DQK / 16];
    const bf16* Qw = Qb + (size_t)(wid * QBLK + r32) * D + hi * 8;
#pragma unroll
    for (int d0 = 0; d0 < DQK / 16; ++d0) qr[d0] = *reinterpret_cast<const bf16x8*>(Qw + d0 * 16);
    const int qpos = qpos0 + wid * QBLK + r32;
    const float qrel0 = (float)(qpos - 4 * hi - kshift);
    const int vsr = tid >> 4, vsc = (tid & 15) * 8, vst0 = v_st(vsr, vsc), vst1 = v_st(32 + vsr, vsc);
    const int ksr = (DQK == 128) ? (tid >> 4) : (tid >> 3), ksc = (DQK == 128) ? (tid & 15) * 8 : (tid & 7) * 8;
    const int kst0 = kswz<DQK>(ksr, ksc * 2), kst1 = kswz<DQK>(32 + ksr, ksc * 2);
    const int vb0 = (int)(uintptr_t)V_lds + v_rd_base(lane);
    struct { bf16x8 vs0, vs1, ks0, ks1; unsigned long long mk; } sr_[SDEPTH];
    unsigned long long mkb0 = 0ull, mkb1 = 0ull;
    const unsigned long long* mrow = DSA ? (mask + (qpos0 + wid * QBLK + r32)) : nullptr;
#define ATT_SLOAD(i, t) do { const int k0_ = (t) * KVBLK; \
    sr_[i].vs0 = *reinterpret_cast<const bf16x8*>(&Vh[(size_t)(k0_ + vsr) * D + vsc]); sr_[i].vs1 = *reinterpret_cast<const bf16x8*>(&Vh[(size_t)(k0_ + 32 + vsr) * D + vsc]); \
    sr_[i].ks0 = *reinterpret_cast<const bf16x8*>(&Kh[(size_t)(k0_ + ksr) * D + ksc]); \
    if constexpr (DQK == 128) sr_[i].ks1 = *reinterpret_cast<const bf16x8*>(&Kh[(size_t)(k0_ + 32 + ksr) * D + ksc]); \
    if constexpr (DSA) sr_[i].mk = mrow[(size_t)(t) * S]; } while (0)
#define ATT_SWRITE(b, i) do { *(bf16x8*)(V_lds + (b) * SHM_V + vst0) = sr_[i].vs0; *(bf16x8*)(V_lds + (b) * SHM_V + vst1) = sr_[i].vs1; \
    *(bf16x8*)(K_lds + (b) * SHM_K + kst0) = sr_[i].ks0; \
    if constexpr (DQK == 128) *(bf16x8*)(K_lds + (b) * SHM_K + kst1) = sr_[i].ks1; \
    if constexpr (DSA) { if ((b) == 0) mkb0 = sr_[i].mk; else mkb1 = sr_[i].mk; } } while (0)
#define ATT_SWAIT() do { if constexpr (SDEPTH == 1) asm volatile("s_waitcnt vmcnt(0)" ::: "memory"); else if constexpr (DSA) asm volatile("s_waitcnt vmcnt(5)" ::: "memory"); else if constexpr (DQK == 128) asm volatile("s_waitcnt vmcnt(4)" ::: "memory"); else asm volatile("s_waitcnt vmcnt(3)" ::: "memory"); } while (0)
    const float sl = -nslope, sl64 = sl * 64.f, chi = sl * (float)(4 * hi);
    const int jband = NT - 5;
    float m0;
    { float qn = 0.f;
#pragma unroll
      for (int d0 = 0; d0 < DQK / 16; ++d0)
#pragma unroll
          for (int e = 0; e < 4; ++e) { const unsigned w = ((const unsigned*)&qr[d0])[e]; const float a = bflo(w), b = bfhi(w); qn += a * a + b * b; }
      { auto rr = __builtin_amdgcn_permlane32_swap(__float_as_uint(qn), __float_as_uint(qn), false, false); qn = __uint_as_float(rr[0]) + __uint_as_float(rr[1]); }
      int dn = 0; if constexpr (DSA) dn = (int)nsd[qpos];
      m0 = sl * (float)(qpos - kshift - dn) + (sqrtf(qn * kmax2) * 1.002f + 0.05f) - chi; }
#define ATT_QK(P0, P1, KB, t, MK) do { const bool vis_ = (t) <= tmaxw; float cin_ = sl64 * (float)(t) - m0; unsigned mlo_ = 0u, mhi_ = 0u; \
    if constexpr (DSA) { const unsigned long long mk_ = vis_ ? (MK) : 0ull; mlo_ = (unsigned)(mk_ & 0xffffffffull) >> (4 * hi); mhi_ = (unsigned)(mk_ >> 32) >> (4 * hi); } \
    else { cin_ = vis_ ? cin_ : -__builtin_inff(); } \
    qkt_init<DQK, DSA>(P0, P1, (KB), qr, r32, hi, cin_, mlo_, mhi_); } while (0)
#define ATT_BX(P0, P1, t) do { float qrel_ = qrel0 - (float)((t) * KVBLK); float sl_ = sl; asm volatile("" : "+v"(qrel_), "+v"(sl_)); bias_exp(P0, P1, sl_, (t) >= jband, qrel_); } while (0)
    f32x16 pA0, pA1, pB0, pB1; bf16x8 pa0, pa1, pa2, pa3;
    constexpr int SE = 0, SO = SDEPTH - 1;
    __syncthreads();
    ATT_SLOAD(SE, 0); asm volatile("s_waitcnt vmcnt(0)" ::: "memory"); ATT_SWRITE(0, SE); __syncthreads();
    ATT_QK(pA0, pA1, K_lds, 0, mkb0); ATT_BX(pA0, pA1, 0);
    ATT_SLOAD(SO, 1); if constexpr (SDEPTH == 2) { ATT_SLOAD(SE, 2); }
    ATT_SWAIT(); ATT_SWRITE(1, SO); __syncthreads();
    if (wid >= 4) __builtin_amdgcn_s_setprio(1);
    for (int j = 1; j + 1 < NT; j += 2) {
        if constexpr (SDEPTH == 1) { ATT_SLOAD(SO, j + SDEPTH); ASBAR(); }
        ASBAR(); ATT_QK(pB0, pB1, K_lds + SHM_K, j, mkb1);
        finishSM(pA0, pA1, 1.f, l_reg, pa0, pa1, pa2, pa3); ASBAR();
        if constexpr (SDEPTH != 1) { ATT_SLOAD(SO, j + SDEPTH); ASBAR(); }
        pv_d0(o, vb0, pa0, pa1, pa2, pa3); ATT_BX(pB0, pB1, j);
        __syncthreads(); ATT_SWAIT(); ATT_SWRITE(0, SE);
        __syncthreads();
        if constexpr (SDEPTH == 1) { ATT_SLOAD(SE, j + 1 + SDEPTH); ASBAR(); }
        ASBAR(); ATT_QK(pA0, pA1, K_lds, j + 1, mkb0);
        finishSM(pB0, pB1, 1.f, l_reg, pa0, pa1, pa2, pa3); ASBAR();
        if constexpr (SDEPTH != 1) { ATT_SLOAD(SE, (j + 3 < NT) ? j + 3 : NT - 1); ASBAR(); }
        pv_d0(o, vb0 + SHM_V, pa0, pa1, pa2, pa3); ATT_BX(pA0, pA1, j + 1);
        __syncthreads(); ATT_SWAIT(); ATT_SWRITE(1, SO);
        __syncthreads();
    }
    __builtin_amdgcn_s_setprio(0);
    ASBAR(); ATT_QK(pB0, pB1, K_lds + SHM_K, NT - 1, mkb1);
    finishSM(pA0, pA1, 1.f, l_reg, pa0, pa1, pa2, pa3); ASBAR();
    pv_d0(o, vb0, pa0, pa1, pa2, pa3); ATT_BX(pB0, pB1, NT - 1);
    __syncthreads();
    finishSM(pB0, pB1, 1.f, l_reg, pa0, pa1, pa2, pa3); ASBAR();
    pv_d0(o, vb0 + SHM_V, pa0, pa1, pa2, pa3);
    if (hi == 0) li_l[r32] = l_reg; asm volatile("s_waitcnt lgkmcnt(0)" ::: "memory");
#pragma unroll
    for (int r = 0; r < 16; ++r) rli[r] = __builtin_amdgcn_rcpf(li_l[crow(r, hi)]);
#undef ATT_SLOAD
#undef ATT_SWRITE
#undef ATT_SWAIT
#undef ATT_QK
#undef ATT_BX
}
}

__device__ __forceinline__ float alibi_slope(int h) { return __builtin_amdgcn_exp2f(-(float)(h + 1)); }

template <int DQK> __device__ __forceinline__ float unit_qmax(Frame& F, const bf16* Qb) {
    LAS unsigned* qm = (LAS unsigned*)(F.lds + L_TINFO);
    const int lane = F.lane, wid = F.wave, r32 = lane & 31, hi = lane >> 5;
    __syncthreads();
    if (F.tid == 0) qm[0] = 0u;
    __syncthreads();
    const bf16* Qw = Qb + (size_t)(wid * 32 + r32) * D + hi * 8;
    float qn = 0.f;
#pragma unroll
    for (int d0 = 0; d0 < DQK / 16; ++d0) { const v4u w4 = *(const v4u*)(Qw + d0 * 16);
#pragma unroll
        for (int e = 0; e < 4; ++e) { const float a = bflo(w4[e]), b = bfhi(w4[e]); qn += a * a + b * b; } }
    qn += __shfl_xor(qn, 32);
#pragma unroll
    for (int o = 1; o < 32; o <<= 1) qn = fmaxf(qn, __shfl_xor(qn, o));
    if (lane == 0) __hip_atomic_fetch_max(&qm[0], __float_as_uint(qn), __ATOMIC_RELAXED, __HIP_MEMORY_SCOPE_WORKGROUP);
    __syncthreads();
    return __uint_as_float(qm[0]);
}
__device__ __forceinline__ int unit_first_tile(int h, int qb, float dsel) {
    const float sl = alibi_slope(h) * LOG2E;
    const float w = 128.f / sl + dsel;
    const float t = floorf(((float)(256 * qb) - w) * (1.f / 64.f));
    int t0 = (t > 0.f) ? (int)t : 0; if (t0 > 4 * qb) t0 = 4 * qb;
    return t0 & ~1;
}
__device__ __forceinline__ void diff_unit(Frame& F, char* lds, int h, int qb, int c, int qword) {
    using namespace att;
    const int lane = F.lane, wid = F.wave, r32 = lane & 31, hi = lane >> 5;
    const bf16* QA = (const bf16*)(F.ws + WS_PROJ) + 0 * PROJ_STRIDE;
    const bf16* KA = (const bf16*)(F.ws + WS_PROJ) + 1 * PROJ_STRIDE;
    const bf16* VA = (const bf16*)(F.ws + WS_PROJ) + 2 * PROJ_STRIDE;
    bf16* OC = (bf16*)(F.ws + WS_SCR) + (size_t)c * PROJ_STRIDE;
    const int q0 = qb * 256;
    const float kmax2 = __uint_as_float(__hip_atomic_load(F.ctl + CW_NRM + 16 + h * 2 + c, RLX_AGENT));
    const int T0 = unit_first_tile(h, qb, 0.f);
    const int NT = 4 * qb + 4 - T0, tmaxw = 4 * qb + (wid >> 1) - T0;
    const float nslope = -alibi_slope(h) * LOG2E;
    const size_t koff = (size_t)T0 * 64 * D;
    f32x16 o[4]; float rli[16];
    attn_body<64, false>(QA + (size_t)q0 * D + h * 128 + c * 64, KA + koff + h * 128 + c * 64, VA + koff + h * 128, NT, tmaxw, q0, 64 * T0, nslope, kmax2, nullptr, nullptr, o, rli, lds);
    int qn_ = 0; if (F.tid == 0) qn_ = (int)__hip_atomic_fetch_add(F.ctl + qword, 1u, RLX_AGENT);
    bf16* Ow = OC + (size_t)(q0 + wid * QBLK + 4 * hi) * D + h * 128 + r32; asm volatile("" : "+v"(Ow));
#pragma unroll
    for (int r = 0; r < 16; ++r) { bf16* op = Ow + (size_t)((r & 3) + 8 * (r >> 2)) * D; if ((r & 3) == 0) asm volatile("" : "+v"(op));
#pragma unroll
        for (int d0 = 0; d0 < 4; ++d0) op[d0 * 32] = (bf16)f2bf(o[d0][r] * rli[r]); }
    if (F.tid == 0) *(LAS int*)(F.lds + L_QI) = qn_;
}
__device__ __forceinline__ void p4c_combine(Frame& F, float lam) {
    const bf16* O0 = (const bf16*)(F.ws + WS_SCR); const bf16* O1 = O0 + PROJ_STRIDE; unsigned char* YA = (unsigned char*)(F.ws + WS_YA);
    const int lane = F.lane, gw = F.bid * NWAVES + F.wave, NGW = F.G * NWAVES;
    f32x4 g[4];
#pragma unroll
    for (int j = 0; j < 4; ++j) g[j] = *((const f32x4*)(FIN(F, 9) + (lane & 7) * 16) + j) * (1.f - LAM_INIT);
    for (int rp_ = 0; rp_ < ((PROBE_DUP == 50) ? 2 : 1); ++rp_)
#pragma unroll 2
    for (int m = gw; m < S; m += NGW) {
        const v4u* a = (const v4u*)(O0 + (size_t)m * D) + 2 * lane; const v4u* b = (const v4u*)(O1 + (size_t)m * D) + 2 * lane;
        const v4u a0 = a[0], a1 = a[1], b0 = b[0], b1 = b[1];
        f32x4 y[4]; float s = 0.f;
#pragma unroll
        for (int j = 0; j < 4; ++j) { const unsigned aw0 = (j < 2) ? a0[2 * j] : a1[2 * j - 4], aw1 = (j < 2) ? a0[2 * j + 1] : a1[2 * j - 3];
            const unsigned bw0 = (j < 2) ? b0[2 * j] : b1[2 * j - 4], bw1 = (j < 2) ? b0[2 * j + 1] : b1[2 * j - 3];
            y[j].x = bflo(aw0) - lam * bflo(bw0); y[j].y = bfhi(aw0) - lam * bfhi(bw0); y[j].z = bflo(aw1) - lam * bflo(bw1); y[j].w = bfhi(aw1) - lam * bfhi(bw1);
            s += (y[j].x * y[j].x + y[j].y * y[j].y) + (y[j].z * y[j].z + y[j].w * y[j].w); }
        s += __shfl_xor(s, 1); s += __shfl_xor(s, 2); s += __shfl_xor(s, 4);
        const float rinv = 1.0f / sqrtf(s * (1.f / 128.f) + LN_EPS);
        v4u w0;
        { const float rs = rinv * Y_FP8_SCALE; const f32x4 t0 = y[0] * rs * g[0], t1 = y[1] * rs * g[1], t2 = y[2] * rs * g[2], t3 = y[3] * rs * g[3];
          w0.x = pk4_fp8(t0.x, t0.y, t0.z, t0.w); w0.y = pk4_fp8(t1.x, t1.y, t1.z, t1.w); w0.z = pk4_fp8(t2.x, t2.y, t2.z, t2.w); w0.w = pk4_fp8(t3.x, t3.y, t3.z, t3.w); }
        *((v4u*)(YA + (size_t)m * D) + lane) = w0;
    }
}

__device__ __forceinline__ void dsa_unit(Frame& F, char* lds, int h, int qb, int qword) {
    using namespace att;
    const int lane = F.lane, wid = F.wave, r32 = lane & 31, hi = lane >> 5;
    const bf16* QB = (const bf16*)(F.ws + WS_PROJ) + 3 * PROJ_STRIDE;
    const bf16* KB = (const bf16*)(F.ws + WS_PROJ) + 4 * PROJ_STRIDE;
    const bf16* VB = (const bf16*)(F.ws + WS_PROJ) + 5 * PROJ_STRIDE;
    unsigned char* YB = (unsigned char*)(F.ws + WS_YB);
    const int q0 = qb * 256;
    const float kmax2 = __uint_as_float(__hip_atomic_load(F.ctl + CW_NRM + 40 + h, RLX_AGENT));
    const int T0 = unit_first_tile(h, qb, (float)__hip_atomic_load(F.ctl + CW_NRM + 64 + qb, RLX_AGENT));
    const int NT = 4 * qb + 4 - T0, tmaxw = 4 * qb + (wid >> 1) - T0;
    const float nslope = -alibi_slope(h) * LOG2E;
    const size_t koff = (size_t)T0 * 64 * D;
    f32x16 o[4]; float rli[16];
    attn_body<128, true>(QB + (size_t)q0 * D + h * 128, KB + koff + h * 128, VB + koff + h * 128, NT, tmaxw, q0, 64 * T0, nslope, kmax2, (const unsigned*)(F.ws + WS_NSD), (const unsigned long long*)(F.ws + WS_MASK) + (size_t)T0 * S, o, rli, lds);
    int qn_ = 0; if (F.tid == 0) qn_ = (int)__hip_atomic_fetch_add(F.ctl + qword, 1u, RLX_AGENT);
    unsigned char* Yw = YB + (size_t)(q0 + wid * QBLK + 4 * hi) * D + h * 128 + r32; asm volatile("" : "+v"(Yw));
#pragma unroll
    for (int r = 0; r < 16; ++r) { unsigned char* yp = Yw + (size_t)((r & 3) + 8 * (r >> 2)) * D; if ((r & 3) == 0) asm volatile("" : "+v"(yp)); const float rs = rli[r] * Y_FP8_SCALE;
#pragma unroll
        for (int d0 = 0; d0 < 4; ++d0) { const float v = o[d0][r] * rs; yp[d0 * 32] = (unsigned char)__builtin_amdgcn_cvt_pk_fp8_f32(v, v, 0, false); } }
    if (F.tid == 0) *(LAS int*)(F.lds + L_QI) = qn_;
}

__device__ __forceinline__ int queue_next(Frame& F, int word);
__device__ __forceinline__ void p3_norms(Frame& F) {
    const bf16* P = (const bf16*)(F.ws + WS_PROJ);
    const int lane = F.lane, gw = F.bid * NWAVES + F.wave, NGW = F.G * NWAVES;
    float mx[4] = {0.f, 0.f, 0.f, 0.f};
#ifndef PROBE_DUP
#define PROBE_DUP -1
#endif
    (void)gw; (void)NGW;
    for (;;) { const int ch = queue_next(F, CW_Q3 + 32); if (ch >= S / 32) break;
    for (int rr_ = 0; rr_ < 4; ++rr_) { const int m = ch * 32 + F.wave * 4 + rr_;
#pragma unroll
        for (int a = 1; a < 4; a += 2) {
            const int buf = (a == 0) ? 0 : (a == 1) ? 1 : (a == 2) ? 3 : 4;
            const v4u* r = (const v4u*)(P + (size_t)buf * PROJ_STRIDE + (size_t)m * D) + 2 * lane;
            const v4u w0 = r[0], w1 = r[1]; float s = 0.f;
#pragma unroll
            for (int e = 0; e < 4; ++e) { const float x0 = bflo(w0[e]), x1 = bfhi(w0[e]), x2 = bflo(w1[e]), x3 = bfhi(w1[e]); s += (x0 * x0 + x1 * x1) + (x2 * x2 + x3 * x3); }
            s += __shfl_xor(s, 1); s += __shfl_xor(s, 2);
            if (a >= 2) s += __shfl_xor(s, 4);
            mx[a] = fmaxf(mx[a], s);
        }
    } }
    if ((lane & 3) == 0) __hip_atomic_fetch_max(F.ctl + CW_NRM + 16 + (lane >> 2), __float_as_uint(mx[1]), RLX_AGENT);
    if ((lane & 7) == 0) __hip_atomic_fetch_max(F.ctl + CW_NRM + 40 + (lane >> 3), __float_as_uint(mx[3]), RLX_AGENT);
}
__device__ __forceinline__ void build_order(Frame& F, int kind) {
    LAS unsigned* key = (LAS unsigned*)(F.lds + L_ORDER); LAS unsigned short* t0tab = (LAS unsigned short*)(F.lds + L_T0);
    __syncthreads();
#pragma unroll
    for (int half = 0; half < 2; ++half) { int u = F.tid + 512 * half; asm volatile("" : "+v"(u)); const int h = (u >> 6) & 7, qb = u & 63;
        if (kind == 0) { const int hc = 15 - (u & 15), q = 63 - (u >> 4); key[u] = (unsigned)((hc & 1) * 512 + (hc >> 1) * 64 + q); }
        else if (half == 0) { key[u] = (unsigned)((7 - (u & 7)) * 64 + (63 - (u >> 3))); }
        (void)h; (void)qb; (void)t0tab; }
    __syncthreads();
}

namespace idx {
using bf16x8 = __attribute__((ext_vector_type(8))) short;
typedef float f4 __attribute__((ext_vector_type(4)));
constexpr int IQ_OFF = 0, CS_OFF = 34816, CI_OFF = 108544;
constexpr int CAP = 1152, NPL = CAP / 64, TRIG = CAP - 512;
constexpr int TRIG2 = 800;
__device__ __forceinline__ unsigned ord(float f) { const unsigned b = __float_as_uint(f); return (b & 0x80000000u) ? ~b : (b | 0x80000000u); }
__device__ __forceinline__ float unord(unsigned u) { return __uint_as_float((u & 0x80000000u) ? (u & 0x7fffffffu) : ~u); }

__device__ __forceinline__ int wave_total(int v) {
    v += __builtin_amdgcn_update_dpp(0, v, 0x111, 0xf, 0xf, true); v += __builtin_amdgcn_update_dpp(0, v, 0x112, 0xf, 0xf, true);
    v += __builtin_amdgcn_update_dpp(0, v, 0x114, 0xf, 0xf, true); v += __builtin_amdgcn_update_dpp(0, v, 0x118, 0xf, 0xf, true);
    v += __builtin_amdgcn_update_dpp(0, v, 0x142, 0xa, 0xf, false);
    v += __builtin_amdgcn_update_dpp(0, v, 0x143, 0xc, 0xf, false);
    return __builtin_amdgcn_readlane(v, 63);
}
__device__ __forceinline__ unsigned wave_umax(unsigned v) {
    v = max(v, (unsigned)__builtin_amdgcn_update_dpp(0, (int)v, 0x111, 0xf, 0xf, true)); v = max(v, (unsigned)__builtin_amdgcn_update_dpp(0, (int)v, 0x112, 0xf, 0xf, true));
    v = max(v, (unsigned)__builtin_amdgcn_update_dpp(0, (int)v, 0x114, 0xf, 0xf, true)); v = max(v, (unsigned)__builtin_amdgcn_update_dpp(0, (int)v, 0x118, 0xf, 0xf, true));
    v = max(v, (unsigned)__builtin_amdgcn_update_dpp(0, (int)v, 0x142, 0xa, 0xf, false));
    v = max(v, (unsigned)__builtin_amdgcn_update_dpp(0, (int)v, 0x143, 0xc, 0xf, false));
    return (unsigned)__builtin_amdgcn_readlane((int)v, 63);
}
__device__ __forceinline__ void prune_row(LAS unsigned char* lds, int row, int n, int lane, bool exact) {
    LAS float* cs = (LAS float*)(lds + CS_OFF) + row * CAP;
    LAS unsigned short* ci = (LAS unsigned short*)(lds + CI_OFF) + row * CAP;
    unsigned u[NPL]; unsigned id[NPL];
    { float f_[NPL];
#pragma unroll
      for (int i = 0; i < NPL; ++i) { const int e = lane + 64 * i; f_[i] = cs[e]; id[i] = ci[e]; }
      __builtin_amdgcn_sched_barrier(0);
#pragma unroll
      for (int i = 0; i < NPL; ++i) { const bool v = (lane + 64 * i) < n; u[i] = v ? ord(f_[i]) : 0u; id[i] = v ? id[i] : 0xffffu; } }
    unsigned umx = 0u;
#pragma unroll
    for (int i = 0; i < NPL; ++i) umx = max(umx, u[i]);
    umx = wave_umax(umx);
    const unsigned ulo = ord(((LAS float*)(lds + L_BASE))[row]);
    const unsigned dif = ulo ^ umx;
    const int topbit = dif ? (31 - __builtin_clz(dif)) : -1;
    const unsigned T0 = (topbit >= 31) ? 0u : ((topbit < 0) ? ulo : (ulo & ~((2u << topbit) - 1u)));
    unsigned T = T0;
    int cT = n;
#ifndef PROBE_DUP
#define PROBE_DUP -1
#endif
#pragma unroll 1
    for (int rp_ = 0; rp_ < ((PROBE_DUP == 33) ? 2 : 1); ++rp_) { T = T0; cT = n; asm volatile("" : "+s"(T));
    for (int bit = topbit; bit >= 0; --bit) {
        if (!exact && cT <= 320) break;
        const unsigned cand = T | (1u << bit); int c = 0;
#pragma unroll
        for (int i = 0; i < NPL; ++i) c += (u[i] >= cand) ? 1 : 0;
        c = wave_total(c);
        if (c >= 256) { T = cand; cT = c; }
    } }
    int cgt = 0, ceq = 0;
#pragma unroll
    for (int i = 0; i < NPL; ++i) { cgt += (u[i] > T) ? 1 : 0; ceq += (u[i] == T) ? 1 : 0; }
    cgt = wave_total(cgt); ceq = wave_total(ceq);
    const int need = 256 - cgt;
    unsigned I = 0xffffu;
    if (exact && ceq > need) {
        I = 0u;
        for (int bit = 13; bit >= 0; --bit) {
            const unsigned cand = I | (1u << bit); int c = 0;
#pragma unroll
            for (int i = 0; i < NPL; ++i) c += (u[i] == T && id[i] < cand) ? 1 : 0;
            c = wave_total(c);
            if (c < need) I = cand;
        }
    }
    int base = 0;
#pragma unroll
    for (int i = 0; i < NPL; ++i) {
        const bool k = exact ? ((u[i] > T) || (u[i] == T && id[i] <= I)) : (u[i] >= T);
        const unsigned long long b = __ballot(k);
        const int pos = base + (int)__builtin_amdgcn_mbcnt_hi((unsigned)(b >> 32), __builtin_amdgcn_mbcnt_lo((unsigned)b, 0u));
        if (k) { cs[pos] = unord(u[i]); ci[pos] = (unsigned short)id[i]; }
        base += __builtin_popcountll(b);
    }
    if (lane == 0) { ((LAS unsigned*)(lds + L_CNT))[row] = (unsigned)base; ((LAS float*)(lds + L_BASE))[row] = unord(T); }
}

template <int TPR> __device__ __forceinline__ bool idx_rounds(LAS unsigned char* lds, const bf16* KI, int ntiles, int q, int kg, int wave, int lane, LAS unsigned* cnt, LAS float* thr, LAS float* wl) {
    LAS float* cs = (LAS float*)(lds + CS_OFF) + q * CAP;
    LAS unsigned short* ci = (LAS unsigned short*)(lds + CI_OFF) + q * CAP;
    const int nrounds = (ntiles + 8 * TPR - 1) / (8 * TPR);
    bf16x8 kf[4][2];
#define IDX_LOADK(jj) do { _Pragma("unroll") for (int st = 0; st < 4; ++st) _Pragma("unroll") for (int s_ = 0; s_ < 2; ++s_) \
        kf[st][s_] = *(const bf16x8*)(KI + (size_t)((jj) * 64 + st * 16 + q) * 64 + s_ * 32 + kg * 8); } while (0)
    if (wave < ntiles) IDX_LOADK(wave);
    for (int rd = 0; rd < nrounds; ++rd) {
#pragma unroll 1
        for (int tt = 0; tt < TPR; ++tt) {
        const int j = (rd * TPR + tt) * 8 + wave;
        if (j < ntiles) {
            f4 sc[4];
#ifndef PROBE_DUP
#define PROBE_DUP -1
#endif
#pragma unroll 1
            for (int rp_ = 0; rp_ < ((PROBE_DUP == 30) ? 2 : 1); ++rp_) {
#pragma unroll
            for (int st = 0; st < 4; ++st) sc[st] = (f4){0.f, 0.f, 0.f, 0.f};
#define IDX_MM(R, g_) do { const LAS unsigned char* qp_ = lds + IQ_OFF + (g_) * 2048 + lane * 16; \
                const bf16x8 qf0_ = *(const LAS bf16x8*)(qp_); const bf16x8 qf1_ = *(const LAS bf16x8*)(qp_ + 1024); \
                _Pragma("unroll") for (int st = 0; st < 4; ++st) R[st] = __builtin_amdgcn_mfma_f32_16x16x32_bf16(kf[st][0], qf0_, (f4){0.f, 0.f, 0.f, 0.f}, 0, 0, 0); \
                _Pragma("unroll") for (int st = 0; st < 4; ++st) R[st] = __builtin_amdgcn_mfma_f32_16x16x32_bf16(kf[st][1], qf1_, R[st], 0, 0, 0); } while (0)
#define IDX_FOLD(R, wv) do { _Pragma("unroll") for (int st = 0; st < 4; ++st) _Pragma("unroll") for (int e = 0; e < 4; ++e) \
                { float t_ = __builtin_fmaf(__builtin_fabsf(R[st][e]), (wv), sc[st][e]); asm("" : "+v"(t_)); sc[st][e] = t_; } } while (0)
#define IDX_FOLDP(R, wv) do { _Pragma("unroll") for (int st = 0; st < 4; ++st) _Pragma("unroll") for (int e = 0; e < 4; ++e) \
                sc[st][e] = __builtin_fmaf(R[st][e], (wv), sc[st][e]); } while (0)
            f4 ra[4], rb[4];
            IDX_MM(ra, 0);
#pragma unroll 1
            for (int g2 = 0; g2 < 8; ++g2) {
                const float w0 = 0.5f * wl[q * 16 + 2 * g2], w1 = 0.5f * wl[q * 16 + 2 * g2 + 1];
                IDX_MM(rb, 2 * g2 + 1);
                IDX_FOLD(ra, w0);
                IDX_MM(ra, 2 * g2 + 2);
                IDX_FOLD(rb, w1);
            }
            IDX_FOLDP(ra, 0.5f);
#undef IDX_MM
#undef IDX_FOLD
#undef IDX_FOLDP
            }
            if (j + 8 < ntiles) IDX_LOADK(j + 8);
            const float th = thr[q];
            int c = 0;
#pragma unroll
            for (int st = 0; st < 4; ++st)
#pragma unroll
                for (int e = 0; e < 4; ++e) c += (sc[st][e] > th) ? 1 : 0;
            unsigned pos = 0u;
            if (c) pos = __hip_atomic_fetch_add(&cnt[q], (unsigned)c, __ATOMIC_RELAXED, __HIP_MEMORY_SCOPE_WORKGROUP);
            asm volatile("" : "+v"(pos));
#pragma unroll
            for (int st = 0; st < 4; ++st)
#pragma unroll
                for (int e = 0; e < 4; ++e) {
                    const float v = sc[st][e];
                    if (v > th) { if (pos < (unsigned)CAP) { cs[pos] = v; ci[pos] = (unsigned short)(j * 64 + st * 16 + kg * 4 + e); } ++pos; }
                }
        } }
        __syncthreads();
        if constexpr (TPR > 1) { if (__any(lane < 16 && cnt[lane & 15] > (unsigned)((PROBE_DUP == 31) ? 900 : CAP))) return true; }
        const bool last = (rd == nrounds - 1);
        const bool anyover = __any(lane < 16 && cnt[lane & 15] > (unsigned)(TPR > 1 ? TRIG2 : TRIG));
        if (last || anyover) {
#pragma unroll
            for (int rr = 0; rr < 2; ++rr) { const int row = wave + 8 * rr; int c = (int)cnt[row]; c = c > CAP ? CAP : c;
                if (last ? (c > 256) : (c > 320)) prune_row(lds, row, c, lane, last); }
        }
        __syncthreads();
    }
#undef IDX_LOADK
    return false;
}
__device__ __forceinline__ void index_unit(Frame& F, int ub) {
    LAS unsigned char* lds = F.lds;
    const int tid = F.tid, lane = F.lane, wave = F.wave;
    const int q0 = ub * 16, N = ((q0 >> 6) + 1) << 6, ntiles = N >> 6;
    unsigned long long* M = (unsigned long long*)(F.ws + WS_MASK);
    if (N <= 256) {
        for (int p = tid; p < ntiles * 16; p += 512) M[(size_t)(p >> 4) * S + q0 + (p & 15)] = ~0ull;
        if (tid < 16) ((unsigned*)(F.ws + WS_NSD))[q0 + tid] = 0u;
        return;
    }
    const bf16* QI = (const bf16*)(F.ws + WS_PROJ) + 6 * PROJ_STRIDE;
    const bf16* KI = (const bf16*)(F.ws + WS_KI);
    const float* WI = (const float*)(F.ws + WS_WI);
    LAS unsigned* cnt = (LAS unsigned*)(lds + L_CNT);
    LAS float* thr = (LAS float*)(lds + L_BASE);
    __syncthreads();
#pragma unroll
    for (int i = 0; i < 4; ++i) { const int p = tid + 512 * i, q = p >> 7, ch = p & 127, g = ch >> 3, s = (ch >> 2) & 1, kg = ch & 3;
        const v4u v = *(const v4u*)(QI + (size_t)(q0 + q) * D + ch * 8);
        *(LAS v4u*)(lds + IQ_OFF + ((g * 2 + s) * 4 + kg) * 256 + q * 16) = v; }
    if (tid < 16) { cnt[tid] = 0u; thr[tid] = -__builtin_inff(); }
    const int q = lane & 15, kg = lane >> 4;
    LAS float* wl = (LAS float*)(lds + L_TINFO);
    if (tid < 256) wl[tid] = WI[(size_t)q0 * 16 + tid];
    __syncthreads();
    { const int q_ = tid >> 5, dp = (tid & 31) * 2;
      const int s_ = dp >> 5, kg_ = (dp & 31) >> 3, o_ = ((s_ * 4 + kg_) * 256) + q_ * 16 + (dp & 7) * 2;
      float a0 = 0.f, a1 = 0.f;
#pragma unroll
      for (int g = 0; g < 16; ++g) { const unsigned w2 = *(const LAS unsigned*)(lds + IQ_OFF + g * 2048 + o_); const float wg = wl[q_ * 16 + g]; a0 = __builtin_fmaf(wg, bflo(w2), a0); a1 = __builtin_fmaf(wg, bfhi(w2), a1); }
      *(LAS unsigned*)(lds + IQ_OFF + 16 * 2048 + o_) = pk2(a0, a1); }
    __syncthreads();
    if (idx_rounds<2>(lds, KI, ntiles, q, kg, wave, lane, cnt, thr, wl)) {
        __syncthreads();
        if (tid < 16) { cnt[tid] = 0u; thr[tid] = -__builtin_inff(); }
        __syncthreads();
        idx_rounds<1>(lds, KI, ntiles, q, kg, wave, lane, cnt, thr, wl);
    }
    LAS unsigned* bm = (LAS unsigned*)(lds + IQ_OFF);
    for (int p = tid; p < 16 * 512; p += 512) bm[p] = 0u;
    __syncthreads();
    if (tid < 16) cnt[tid] = 0x7fffffffu;
    __syncthreads();
    for (int p = tid; p < 16 * 256; p += 512) { const int row = p >> 8, k = p & 255;
        const unsigned key = ((LAS unsigned short*)(lds + CI_OFF))[row * CAP + k];
        __hip_atomic_fetch_or(&bm[row * 512 + (key >> 5)], 1u << (key & 31), __ATOMIC_RELAXED, __HIP_MEMORY_SCOPE_WORKGROUP);
        const int dd = (q0 + row) - (int)key; __hip_atomic_fetch_min(&cnt[row], (unsigned)(dd < 0 ? -dd : dd), __ATOMIC_RELAXED, __HIP_MEMORY_SCOPE_WORKGROUP); }
    __syncthreads();
    if (tid < 16) { __hip_atomic_fetch_max(F.ctl + CW_NRM + 64 + (q0 >> 8), cnt[tid], RLX_AGENT); ((unsigned*)(F.ws + WS_NSD))[q0 + tid] = cnt[tid]; }
    for (int p = tid; p < ntiles * 16; p += 512) { const int t = p >> 4, row = p & 15;
        const unsigned lo = bm[row * 512 + 2 * t], hiw = bm[row * 512 + 2 * t + 1];
        M[(size_t)t * S + q0 + row] = ((unsigned long long)hiw << 32) | lo; }
}
}

__device__ __forceinline__ void p0_mod(Frame& F) {
    if (F.bid < 96) {
        const int col = F.bid * 64 + F.lane, k0 = F.wave * 128;
        float acc = 0.f;
#pragma unroll 8
        for (int k = 0; k < 128; ++k) { const float cv = FIN(F, 1)[k0 + k]; const float sl = cv / (1.f + __expf(-cv)); acc = __builtin_fmaf(sl, FIN(F, 2)[(size_t)(k0 + k) * 6144 + col], acc); }
        LAS float* red = (LAS float*)(F.lds + RING_OFF + 8 * 16384 - 4096);
        red[F.wave * 64 + F.lane] = acc;
        __syncthreads();
        if (F.wave == 0) { float s = 0.f;
#pragma unroll
            for (int w = 0; w < 8; ++w) s += red[w * 64 + F.lane];
            ((float*)(F.ws + WS_SMALL))[col] = s + FIN(F, 3)[col]; }
        __syncthreads();
    }
}
template <class Map>
__device__ __forceinline__ void transpose_item(const float* W, int K, int N, bf16* WT, LAS float* scr, int item, int lane, Map map) {
    const int nblk = (N + 31) / 32, kb = item / nblk, nb = item % nblk, k0 = 64 * kb, n0 = 32 * nb;
    const int ncol = n0 + (lane & 31); const bool ok = ncol < N;
#pragma unroll 8
    for (int i = 0; i < 32; ++i) { const int kk = 2 * i + (lane >> 5); scr[kk * 33 + (lane & 31)] = ok ? W[(size_t)(k0 + kk) * N + ncol] : 0.f; }
    LDS_WAIT(); asm volatile("" ::: "memory");
    const int c = lane & 7;
#pragma unroll
    for (int j = 0; j < 4; ++j) { const int n = (lane >> 3) + 8 * j; const LAS float* s = scr + (8 * c) * 33 + n;
        v4u o; o.x = pk2(s[0 * 33], s[1 * 33]); o.y = pk2(s[2 * 33], s[3 * 33]); o.z = pk2(s[4 * 33], s[5 * 33]); o.w = pk2(s[6 * 33], s[7 * 33]);
        if (n0 + n < N) *(GAS v4u*)(WT + (size_t)map(n0 + n) * K + k0 + 8 * c) = o; }
    LDS_WAIT(); asm volatile("" ::: "memory");
}
__device__ __forceinline__ void transpose_item_fp8(const float* W, int K, int N, unsigned char* WT, LAS float* scr, int item, int lane, float scale) {
    const int nblk = N / 32, kb = item / nblk, nb = item % nblk, k0 = 64 * kb, n0 = 32 * nb;
    { f32x4 v[8]; const int c4 = (lane & 7) * 4, kr = lane >> 3;
#pragma unroll
      for (int i = 0; i < 8; ++i) v[i] = *(const f32x4*)(W + (size_t)(k0 + 8 * i + kr) * N + n0 + c4);
#pragma unroll
      for (int i = 0; i < 8; ++i) { LAS float* d = scr + (8 * i + kr) * 33 + c4; d[0] = v[i].x; d[1] = v[i].y; d[2] = v[i].z; d[3] = v[i].w; } }
    LDS_WAIT(); asm volatile("" ::: "memory");
    const int n = lane >> 1, hf = lane & 1; const LAS float* s = scr + (32 * hf) * 33 + n;
    v4u o0, o1;
#pragma unroll
    for (int j = 0; j < 4; ++j) { o0[j] = pk4_fp8(s[(4 * j) * 33] * scale, s[(4 * j + 1) * 33] * scale, s[(4 * j + 2) * 33] * scale, s[(4 * j + 3) * 33] * scale);
        o1[j] = pk4_fp8(s[(16 + 4 * j) * 33] * scale, s[(17 + 4 * j) * 33] * scale, s[(18 + 4 * j) * 33] * scale, s[(19 + 4 * j) * 33] * scale); }
    GAS v4u* d = (GAS v4u*)(WT + (size_t)(n0 + n) * K + k0 + 32 * hf); d[0] = o0; d[1] = o1;
    LDS_WAIT(); asm volatile("" ::: "memory");
}
template <int NI> __device__ __forceinline__ void transpose_items_fp8(const float* W, int K, int N, unsigned char* WT, LAS float* scr, int item0, int lane, float scale) {
    const int nblk = N / 32, c4 = (lane & 7) * 4, kr = lane >> 3;
    f32x4 v[NI][8];
#pragma unroll
    for (int t = 0; t < NI; ++t) { const int item = item0 + t, kb = item / nblk, nb = item % nblk; const float* src = W + (size_t)(64 * kb + kr) * N + 32 * nb + c4;
#pragma unroll
        for (int i = 0; i < 8; ++i) v[t][i] = *(const f32x4*)(src + (size_t)(8 * i) * N); }
    __builtin_amdgcn_sched_barrier(0);
#pragma unroll
    for (int t = 0; t < NI; ++t) { const int item = item0 + t, kb = item / nblk, nb = item % nblk, k0 = 64 * kb, n0 = 32 * nb;
#pragma unroll
        for (int i = 0; i < 8; ++i) { LAS float* d = scr + (8 * i + kr) * 33 + c4; d[0] = v[t][i].x; d[1] = v[t][i].y; d[2] = v[t][i].z; d[3] = v[t][i].w; }
        LDS_WAIT(); asm volatile("" ::: "memory");
        const int n = lane >> 1, hf = lane & 1; const LAS float* s = scr + (32 * hf) * 33 + n;
        v4u o0, o1;
#pragma unroll
        for (int j = 0; j < 4; ++j) { o0[j] = pk4_fp8(s[(4 * j) * 33] * scale, s[(4 * j + 1) * 33] * scale, s[(4 * j + 2) * 33] * scale, s[(4 * j + 3) * 33] * scale);
            o1[j] = pk4_fp8(s[(16 + 4 * j) * 33] * scale, s[(17 + 4 * j) * 33] * scale, s[(18 + 4 * j) * 33] * scale, s[(19 + 4 * j) * 33] * scale); }
        GAS v4u* d = (GAS v4u*)(WT + (size_t)(n0 + n) * K + k0 + 32 * hf); d[0] = o0; d[1] = o1;
        LDS_WAIT(); asm volatile("" ::: "memory"); }
}
struct MapId { __device__ __forceinline__ int operator()(int n) const { return n; } };
__device__ __forceinline__ int win_route(int n, bool& is16) {
    if (n < 6144) { is16 = false; return n; }
    if (n < 7168) { is16 = true; return n - 6144; }
    if (n < 7232) { is16 = true; return 1024 + (n - 7168); }
    if (n < 7248) { is16 = true; return 1088 + (n - 7232); }
    is16 = false; return 6144 + (n - 7248);
}
__device__ __forceinline__ void transpose_item_win(const float* W, bf16* WT16, unsigned char* WT8, LAS float* scr, int item, int lane) {
    constexpr int K = D, N = NIN;
    const int nblk = (N + 31) / 32, kb = item / nblk, nb = item % nblk, k0 = 64 * kb, n0 = 32 * nb;
    { f32x4 v[8]; const int c4 = (lane & 7) * 4, kr = lane >> 3; const bool ok = n0 + c4 < N;
#pragma unroll
      for (int i = 0; i < 8; ++i) v[i] = ok ? *(const f32x4*)(W + (size_t)(k0 + 8 * i + kr) * N + n0 + c4) : (f32x4){0.f, 0.f, 0.f, 0.f};
#pragma unroll
      for (int i = 0; i < 8; ++i) { LAS float* d = scr + (8 * i + kr) * 33 + c4; d[0] = v[i].x; d[1] = v[i].y; d[2] = v[i].z; d[3] = v[i].w; } }
    LDS_WAIT(); asm volatile("" ::: "memory");
    { const int c = lane & 7;
#pragma unroll
      for (int j = 0; j < 4; ++j) { const int n = (lane >> 3) + 8 * j; const LAS float* s = scr + (8 * c) * 33 + n; bool is16; const int row = win_route(n0 + n, is16);
          v4u o; o.x = pk2(s[0 * 33], s[1 * 33]); o.y = pk2(s[2 * 33], s[3 * 33]); o.z = pk2(s[4 * 33], s[5 * 33]); o.w = pk2(s[6 * 33], s[7 * 33]);
          if (n0 + n < N && is16) *(GAS v4u*)(WT16 + (size_t)row * K + k0 + 8 * c) = o; } }
    { const int n = lane >> 1, hf = lane & 1; const LAS float* s = scr + (32 * hf) * 33 + n; bool is16; const int row = win_route(n0 + n, is16);
      v4u o0, o1;
#pragma unroll
      for (int j = 0; j < 4; ++j) { o0[j] = pk4_fp8(s[(4 * j) * 33] * WIN_FP8_SCALE, s[(4 * j + 1) * 33] * WIN_FP8_SCALE, s[(4 * j + 2) * 33] * WIN_FP8_SCALE, s[(4 * j + 3) * 33] * WIN_FP8_SCALE);
          o1[j] = pk4_fp8(s[(16 + 4 * j) * 33] * WIN_FP8_SCALE, s[(17 + 4 * j) * 33] * WIN_FP8_SCALE, s[(18 + 4 * j) * 33] * WIN_FP8_SCALE, s[(19 + 4 * j) * 33] * WIN_FP8_SCALE); }
      if (n0 + n < N && !is16) { GAS v4u* d = (GAS v4u*)(WT8 + (size_t)row * K + k0 + 32 * hf); d[0] = o0; d[1] = o1; } }
    LDS_WAIT(); asm volatile("" ::: "memory");
}
constexpr int WI_IN = 16 * 291, WI_SQ = 16 * 32, WI_E1 = 16 * 64, WI_E2 = 16 * 32;
constexpr int W_EARLY = WI_IN + 3 * WI_SQ, W_LATE = NE * WI_E1 + NE * WI_E2;
__device__ __forceinline__ void weight_items(Frame& F, int qword, int lo, int hi) {
    LAS float* scr = (LAS float*)(F.lds + RING_OFF + F.wave * 16384);
    LAS int* qw = (LAS int*)(F.lds + L_QI);
    for (;;) {
        __syncthreads();
        if (F.tid == 0) qw[0] = (int)__hip_atomic_fetch_add(F.ctl + qword, 64u, RLX_AGENT);
        __syncthreads();
        const int base = lo + qw[0];
        if (base >= hi) break;
        if (base >= W_EARLY) {
#pragma unroll 1
            for (int k = 0; k < 8; k += 4) { int r = base + F.wave * 8 + k - W_EARLY; if (r + W_EARLY >= hi) break;
                if (r < NE * WI_E1) { const int e = r / WI_E1; transpose_items_fp8<4>(FIN(F, 17) + (size_t)e * D * 2 * FF, D, 2 * FF, (unsigned char*)(F.ws + WS_W1) + (size_t)e * 2 * FF * D, scr, r % WI_E1, F.lane, W1_FP8_SCALE); }
                else { r -= NE * WI_E1; const int e = r / WI_E2; transpose_items_fp8<4>(FIN(F, 19) + (size_t)e * FF * D, FF, D, (unsigned char*)(F.ws + WS_W2) + (size_t)e * D * FF, scr, r % WI_E2, F.lane, W2_FP8_SCALE); } }
            continue; }
#pragma unroll 1
        for (int k = 0; k < 8; ++k) {
        int r = base + F.wave * 8 + k; if (r >= hi) break;
        if (r < WI_IN) { transpose_item_win(FIN(F, 4), (bf16*)(F.ws + WS_WIN), (unsigned char*)(F.ws + WS_WIN8), scr, r, F.lane); continue; } r -= WI_IN;
        if (r < WI_SQ) { transpose_item_fp8(FIN(F, 10), D, D, (unsigned char*)(F.ws + WS_WA), scr, r, F.lane, WAB_FP8_SCALE); continue; } r -= WI_SQ;
        if (r < WI_SQ) { transpose_item_fp8(FIN(F, 11), D, D, (unsigned char*)(F.ws + WS_WB), scr, r, F.lane, WAB_FP8_SCALE); continue; } r -= WI_SQ;
        if (r < WI_SQ) { transpose_item_fp8(FIN(F, 12), D, D, (unsigned char*)(F.ws + WS_WO), scr, r, F.lane, WO_FP8_SCALE); continue; } r -= WI_SQ;
        if (r < NE * WI_E1) { const int e = r / WI_E1; transpose_item_fp8(FIN(F, 17) + (size_t)e * D * 2 * FF, D, 2 * FF, (unsigned char*)(F.ws + WS_W1) + (size_t)e * 2 * FF * D, scr, r % WI_E1, F.lane, W1_FP8_SCALE); continue; } r -= NE * WI_E1;
        { const int e = r / WI_E2; transpose_item_fp8(FIN(F, 19) + (size_t)e * FF * D, FF, D, (unsigned char*)(F.ws + WS_W2) + (size_t)e * D * FF, scr, r % WI_E2, F.lane, W2_FP8_SCALE); }
        }
    }
    __syncthreads();
}
__device__ __forceinline__ void p0_weights(Frame& F) { weight_items(F, CW_P0, 0, W_EARLY); }
__device__ __forceinline__ void ln_mod_row(const float* xrow, bf16* orow, unsigned char* orow8, const float* sc, const float* sh, int lane) {
    const f32x4* xr = (const f32x4*)xrow + lane;
    f32x4 v[4]; float s = 0.f;
#pragma unroll
    for (int j = 0; j < 4; ++j) { v[j] = xr[64 * j]; s += (v[j].x + v[j].y) + (v[j].z + v[j].w); }
    const float mean = wave_sum(s) * (1.f / D); float s2 = 0.f;
#pragma unroll
    for (int j = 0; j < 4; ++j) { v[j] = v[j] - mean; s2 += (v[j].x * v[j].x + v[j].y * v[j].y) + (v[j].z * v[j].z + v[j].w * v[j].w); }
    const float rstd = 1.f / sqrtf(wave_sum(s2) * (1.f / D) + LN_EPS);
    unsigned long long* o8 = (unsigned long long*)orow + lane;
#pragma unroll
    for (int j = 0; j < 4; ++j) { const f32x4 a = *((const f32x4*)sc + lane + 64 * j), b = *((const f32x4*)sh + lane + 64 * j);
        const f32x4 y = v[j] * rstd * (a + 1.f) + b;
        o8[64 * j] = (unsigned long long)pk2(y.x, y.y) | ((unsigned long long)pk2(y.z, y.w) << 32);
        ((unsigned*)orow8)[lane + 64 * j] = pk4_fp8(y.x, y.y, y.z, y.w); }
}
__device__ __forceinline__ void p1_lnmod(Frame& F) {
    const float* mod = (const float*)(F.ws + WS_SMALL);
    const int gw = F.bid * NWAVES + F.wave, NGW = F.G * NWAVES;
#ifndef PROBE_DUP
#define PROBE_DUP -1
#endif
    for (int rp_ = 0; rp_ < ((PROBE_DUP == 50) ? 2 : 1); ++rp_)
#pragma unroll 2
    for (int m = gw; m < S; m += NGW) ln_mod_row(FIN(F, 0) + (size_t)m * D, (bf16*)(F.ws + WS_U) + (size_t)m * D, (unsigned char*)(F.ws + WS_U8) + (size_t)m * D, mod + 1024, mod, F.lane);
}

__device__ __forceinline__ void p7_ln_router(Frame& F) {
    const float* mod = (const float*)(F.ws + WS_SMALL);
    const bf16* Y1 = (const bf16*)(F.ws + WS_Y1); unsigned char* VB = (unsigned char*)(F.ws + WS_VB16);
    LAS float* wrt = (LAS float*)(F.lds + RING_OFF);
    LAS unsigned* lcnt = (LAS unsigned*)(F.lds + L_CNT); LAS unsigned* lbase = (LAS unsigned*)(F.lds + L_BASE);
    LAS unsigned* tinfo = (LAS unsigned*)(F.lds + L_TINFO);
    for (int p = F.tid; p < D * NE; p += 512) { const int k = p >> 5, e = p & 31; wrt[e * D + k] = FIN(F, 15)[p]; }
    if (F.tid < 32) lcnt[F.tid] = 0u;
    __syncthreads();
    const int lane = F.lane, gw = F.bid * NWAVES + F.wave, NGW = F.G * NWAVES;
    for (int rp_ = 0; rp_ < ((PROBE_DUP == 50) ? 2 : 1); ++rp_) {
    int it = 0;
    for (int m = gw; m < S; m += NGW, ++it) {
        const v2u* yr = (const v2u*)(Y1 + (size_t)m * D) + lane;
        f32x4 v[4]; float s = 0.f;
#pragma unroll
        for (int j = 0; j < 4; ++j) { const v2u w = yr[64 * j]; v[j] = (f32x4){bflo(w.x), bfhi(w.x), bflo(w.y), bfhi(w.y)}; s += (v[j].x + v[j].y) + (v[j].z + v[j].w); }
        float mean = wave_sum(s) * (1.f / D); float s2 = 0.f;
#pragma unroll
        for (int j = 0; j < 4; ++j) { v[j] = v[j] - mean; s2 += (v[j].x * v[j].x + v[j].y * v[j].y) + (v[j].z * v[j].z + v[j].w * v[j].w); }
        float rstd = 1.f / sqrtf(wave_sum(s2) * (1.f / D) + LN_EPS);
        s = 0.f;
#pragma unroll
        for (int j = 0; j < 4; ++j) { const f32x4 g = *((const f32x4*)FIN(F, 13) + lane + 64 * j), b = *((const f32x4*)FIN(F, 14) + lane + 64 * j);
            v[j] = v[j] * rstd * g + b; s += (v[j].x + v[j].y) + (v[j].z + v[j].w); }
        mean = wave_sum(s) * (1.f / D); s2 = 0.f;
#pragma unroll
        for (int j = 0; j < 4; ++j) { v[j] = v[j] - mean; s2 += (v[j].x * v[j].x + v[j].y * v[j].y) + (v[j].z * v[j].z + v[j].w * v[j].w); }
        rstd = 1.f / sqrtf(wave_sum(s2) * (1.f / D) + LN_EPS);
        unsigned* o4 = (unsigned*)(VB + (size_t)m * D) + lane;
#pragma unroll
        for (int j = 0; j < 4; ++j) { const f32x4 a = *((const f32x4*)(mod + 4096) + lane + 64 * j), b = *((const f32x4*)(mod + 3072) + lane + 64 * j);
            v[j] = v[j] * rstd * (a + 1.f) + b;
            o4[64 * j] = pk4_fp8(v[j].x, v[j].y, v[j].z, v[j].w); }
        float lgv;
        { float a32[NE];
#pragma unroll
          for (int e = 0; e < NE; ++e) { f32x2 a2 = {0.f, 0.f};
#pragma unroll
              for (int j = 0; j < 4; ++j) { const f32x4 wv = *((const LAS f32x4*)(wrt + e * D) + lane + 64 * j);
                  a2 = __builtin_elementwise_fma(__builtin_shufflevector(v[j], v[j], 0, 1), __builtin_shufflevector(wv, wv, 0, 1), a2);
                  a2 = __builtin_elementwise_fma(__builtin_shufflevector(v[j], v[j], 2, 3), __builtin_shufflevector(wv, wv, 2, 3), a2); }
              a32[e] = a2.x + a2.y; if ((e & 3) == 3) __builtin_amdgcn_sched_barrier(0); }
#define RT_STEP(W, BIT) do { const bool up_ = (lane & (BIT)) != 0; _Pragma("unroll") for (int i = 0; i < (W); ++i) { \
              const float send_ = up_ ? a32[i] : a32[i + (W)], keep_ = up_ ? a32[i + (W)] : a32[i]; a32[i] = keep_ + __shfl_xor(send_, (BIT)); } } while (0)
#define RT_SWAP(W, BUILTIN) do { _Pragma("unroll") for (int i = 0; i < (W); ++i) { const auto rr_ = BUILTIN(__float_as_uint(a32[i]), __float_as_uint(a32[i + (W)]), false, false); \
              a32[i] = __uint_as_float(rr_[0]) + __uint_as_float(rr_[1]); } } while (0)
          RT_SWAP(16, __builtin_amdgcn_permlane32_swap); RT_SWAP(8, __builtin_amdgcn_permlane16_swap);
#undef RT_SWAP
          RT_STEP(4, 8); RT_STEP(2, 4); RT_STEP(1, 2);
#undef RT_STEP
          lgv = a32[0] + __shfl_xor(a32[0], 1);
          lgv += FIN(F, 16)[lane >> 1]; }
        int ei[4]; float ev[4];
        unsigned lgu = idx::ord(lgv);
#pragma unroll
        for (int k = 0; k < 4; ++k) { const unsigned m = idx::wave_umax(lgu);
            const unsigned long long bal = __ballot(lgu == m);
            const int wl_ = (int)__builtin_ctzll(bal) >> 1;
            ei[k] = wl_; ev[k] = idx::unord(m); if ((lane >> 1) == wl_) lgu = idx::ord(-__builtin_inff()); }
        float wsum = 0.f, wk[4];
#pragma unroll
        for (int k = 0; k < 4; ++k) { wk[k] = __expf(ev[k] - ev[0]); wsum += wk[k]; }
        if (lane == 0 && rp_ == 0) {
#pragma unroll
            for (int k = 0; k < 4; ++k) { const unsigned lp = __hip_atomic_fetch_add(&lcnt[ei[k]], 1u, __ATOMIC_RELAXED, __HIP_MEMORY_SCOPE_WORKGROUP);
                LAS unsigned* t = tinfo + ((F.wave * 8 + it) * 4 + k) * 3; t[0] = (unsigned)ei[k]; t[1] = lp; t[2] = __float_as_uint(wk[k] / wsum); }
        }
    } }
    __syncthreads();
    if (F.tid < 32) lbase[F.tid] = __hip_atomic_fetch_add(F.ctl + CW_ECNT + F.tid, lcnt[F.tid], RLX_AGENT);
    __syncthreads();
    if (F.tid < 256) { const int wv = F.tid >> 5, i2 = (F.tid >> 2) & 7, k = F.tid & 3; const int m = (F.bid * NWAVES + wv) + NGW * i2;
        if (m < S) { const LAS unsigned* t = tinfo + ((wv * 8 + i2) * 4 + k) * 3;
            const int e = (int)t[0], pos = (int)(lbase[t[0]] + t[1]);
            ((int*)(F.ws + WS_TOKE))[m * 4 + k] = e; ((int*)(F.ws + WS_TOKP))[m * 4 + k] = pos;
            ((int*)(F.ws + WS_IDXTOK))[(size_t)e * S + pos] = m; ((unsigned*)(F.ws + WS_IDXW))[(size_t)e * S + pos] = t[2]; } }
    __syncthreads();
}
__device__ __forceinline__ void moe_tables(Frame& F) {
    LAS unsigned* off = (LAS unsigned*)(F.lds + L_OFF); LAS unsigned char* texp = (LAS unsigned char*)(F.lds + L_TEXP); LAS int* nt = (LAS int*)(F.lds + L_NT);
    if (F.tid < 64) {
        const int e = F.lane & 31;
        const unsigned c = __hip_atomic_load(F.ctl + CW_ECNT + e, RLX_AGENT);
        const int nte = (F.lane < 32) ? (int)((c + 255u) >> 8) : 0;
        int incl = nte;
#pragma unroll
        for (int o = 1; o < 32; o <<= 1) { const int v = __shfl_up(incl, o); if ((F.lane & 31) >= o) incl += v; }
        const int excl = incl - nte;
        if (F.lane < 32) { ((LAS unsigned*)(F.lds + L_CNT))[e] = c; off[e] = (unsigned)excl << 8; for (int i = 0; i < nte; ++i) if (excl + i < 288) texp[excl + i] = (unsigned char)e; }
        if (F.lane == 31) { off[NE] = (unsigned)incl << 8; nt[0] = incl < 288 ? incl : 288; }
    }
    __syncthreads();
}
__device__ __forceinline__ void p8_dispatch(Frame& F) {
    moe_tables(F);
    const LAS unsigned* off = (const LAS unsigned*)(F.lds + L_OFF);
    const unsigned char* VB = (const unsigned char*)(F.ws + WS_VB16); unsigned char* XS = (unsigned char*)(F.ws + WS_XS);
    const int lane = F.lane, gw = F.bid * NWAVES + F.wave, NGW = F.G * NWAVES;
    for (int rp_ = 0; rp_ < ((PROBE_DUP == 50) ? 2 : 1); ++rp_)
    for (int m = gw; m < S; m += NGW) {
        const v4u a = *((const v4u*)(VB + (size_t)m * D) + lane);
#pragma unroll
        for (int k = 0; k < 4; ++k) { const int e = ((const int*)(F.ws + WS_TOKE))[m * 4 + k], p = ((const int*)(F.ws + WS_TOKP))[m * 4 + k];
            const int slot = (int)off[e] + p;
            *((v4u*)(XS + (size_t)slot * D) + lane) = a;
            if (lane == 0) { ((int*)(F.ws + WS_TOKSLOT))[m * 4 + k] = slot; ((float*)(F.ws + WS_SLOTW))[slot] = ((const float*)(F.ws + WS_TOKW))[m * 4 + k]; } }
    }
}
__device__ __forceinline__ void p11_final(Frame& F) {
    moe_tables(F);
    const float* mod = (const float*)(F.ws + WS_SMALL);
    const bf16* Y1 = (const bf16*)(F.ws + WS_Y1); const unsigned char* O2 = (const unsigned char*)(F.ws + WS_OUT2);
    const int lane = F.lane, gw = F.bid * NWAVES + F.wave, NGW = F.G * NWAVES;
    for (int rp_ = 0; rp_ < ((PROBE_DUP == 50) ? 2 : 1); ++rp_)
#pragma unroll 2
    for (int m = gw; m < S; m += NGW) {
        f32x4 f[4];
#pragma unroll
        for (int j = 0; j < 4; ++j) f[j] = (f32x4){0.f, 0.f, 0.f, 0.f};
#pragma unroll
        for (int k = 0; k < 4; ++k) { const int slot = (int)((const LAS unsigned*)(F.lds + L_OFF))[((const int*)(F.ws + WS_TOKE))[m * 4 + k]] + ((const int*)(F.ws + WS_TOKP))[m * 4 + k];
            const unsigned* r = (const unsigned*)(O2 + (size_t)slot * D) + lane;
#pragma unroll
            for (int j = 0; j < 4; ++j) { const int w = (int)r[64 * j];
                f[j].x += __builtin_amdgcn_cvt_f32_fp8(w, 0); f[j].y += __builtin_amdgcn_cvt_f32_fp8(w, 1); f[j].z += __builtin_amdgcn_cvt_f32_fp8(w, 2); f[j].w += __builtin_amdgcn_cvt_f32_fp8(w, 3); } }
        f32x4 v[4]; float s = 0.f;
        { const v2u* yr = (const v2u*)(Y1 + (size_t)m * D) + lane;
#pragma unroll
          for (int j = 0; j < 4; ++j) { const v2u w = yr[64 * j]; v[j] = (f32x4){bflo(w.x), bfhi(w.x), bflo(w.y), bfhi(w.y)}; s += (v[j].x + v[j].y) + (v[j].z + v[j].w); }
          const float mean1 = wave_sum(s) * (1.f / D); float q1 = 0.f;
#pragma unroll
          for (int j = 0; j < 4; ++j) { v[j] = v[j] - mean1; q1 += (v[j].x * v[j].x + v[j].y * v[j].y) + (v[j].z * v[j].z + v[j].w * v[j].w); }
          const float rstd1 = 1.f / sqrtf(wave_sum(q1) * (1.f / D) + LN_EPS);
#pragma unroll
          for (int j = 0; j < 4; ++j) { const f32x4 g = *((const f32x4*)FIN(F, 13) + lane + 64 * j), b = *((const f32x4*)FIN(F, 14) + lane + 64 * j); v[j] = v[j] * rstd1 * g + b; } }
        s = 0.f;
#pragma unroll
        for (int j = 0; j < 4; ++j) { const f32x4 g = *((const f32x4*)(mod + 5120) + lane + 64 * j);
            v[j] = v[j] * ALPHA + g * (f[j] * (1.f / O2_FP8_SCALE)); s += (v[j].x + v[j].y) + (v[j].z + v[j].w); }
        const float mean = wave_sum(s) * (1.f / D); float s2 = 0.f;
#pragma unroll
        for (int j = 0; j < 4; ++j) { v[j] = v[j] - mean; s2 += (v[j].x * v[j].x + v[j].y * v[j].y) + (v[j].z * v[j].z + v[j].w * v[j].w); }
        const float rstd = 1.f / sqrtf(wave_sum(s2) * (1.f / D) + LN_EPS);
#pragma unroll
        for (int j = 0; j < 4; ++j) { const f32x4 g = *((const f32x4*)FIN(F, 21) + lane + 64 * j), b = *((const f32x4*)FIN(F, 22) + lane + 64 * j);
            *((f32x4*)(F.ap->out + (size_t)m * D) + lane + 64 * j) = v[j] * rstd * g + b; }
    }
}

constexpr int NPHASE = 12;

__device__ __forceinline__ int queue_next(Frame& F, int word) {
    __syncthreads();
    if (F.tid == 0) *(LAS int*)(F.lds + L_QI) = (int)__hip_atomic_fetch_add(F.ctl + word, 1u, RLX_AGENT);
    __syncthreads();
    return *(LAS int*)(F.lds + L_QI);
}

__global__ void __launch_bounds__(NWAVES * 64, 2) block_fwd(Args args) {
    extern __shared__ __attribute__((aligned(16))) unsigned char lds[];
    Frame F;
    F.lds = (LAS unsigned char*)lds;
    F.MISC = (volatile LAS unsigned*)(F.lds + MISC_OFF);
    F.tid = threadIdx.x; F.lane = F.tid & 63; F.wave = __builtin_amdgcn_readfirstlane(F.tid >> 6);
    F.G = gridDim.x; F.bid = blockIdx.x;
    F.ws = args.ws; F.ctl = (gu32*)(args.ws + WS_CTL);
    F.ap = kargs();
    for (int u = F.tid; u < (LDS_BYTES - LDSCTL_OFF) / 4; u += NWAVES * 64) ((LAS unsigned*)(F.lds + LDSCTL_OFF))[u] = 0u;
    __syncthreads();
#if MK_ONE_LAUNCH
    XcdBarrier bar = xcd_barrier_post((unsigned*)(F.ctl + CW_BAR), F.MISC + 8);
#define GRID_BAR() xcd_barrier(bar)
#else
#define GRID_BAR() do {} while (0)
#endif
    const int lo = args.ph_lo, hi = args.ph_hi;
#ifndef PH_MASK
#define PH_MASK 0xfff
#endif
#define IN(k) (((PH_MASK >> (k)) & 1) && lo <= (k) && (k) < hi)
#define SEAM(k) do { if (IN(k) && IN((k) + 1)) { GRID_BAR(); if (PROBE_DUP == 60) GRID_BAR(); } } while (0)
#ifndef PROBE_DUP
#define PROBE_DUP -1
#endif
#define REPS(k)
#define PMUL(k) (((PROBE_DUP == (k)) || (PROBE_DUP == 42 && ((k) == 40 || (k) == 41))) ? 2 : 1)
    constexpr int rep = 0;
    bf16* PROJ = (bf16*)(F.ws + WS_PROJ);

    if (IN(0)) { F.ap = kargs(); p0_mod(F); p0_weights(F); }
    SEAM(0);
    if (IN(1)) { F.ap = kargs(); p1_lnmod(F); }
    SEAM(1);
    if (IN(2)) { F.ap = kargs();
        { pg8::Gemm g{(const pg8::bf16_t*)(F.ws + WS_U8), (const pg8::bf16_t*)(F.ws + WS_WIN8), S, NPROJ8, D / 2}; pg8::StaticOrder So; So.init(S, NPROJ8, F.G, F.bid);
          epi::EpiProj8 E{PROJ};
          epi::ProjOrder Sp{So}; epi::RepOrder<epi::ProjOrder> Sr{Sp, Sp.count(), PMUL(2)};
          pg8::gemm_phase<epi::EpiProj8, epi::RepOrder<epi::ProjOrder>, true, true, true>(F.lds + RING_OFF, g, Sr, E); }
        __syncthreads();
        { pg8::Gemm g{(const pg8::bf16_t*)(F.ws + WS_U), (const pg8::bf16_t*)(F.ws + WS_WIN), S, NPROJ16, D}; pg8::StaticOrder So; So.init(S, NPROJ16, F.G, F.bid);
          epi::EpiProjIdx E{PROJ + 6 * PROJ_STRIDE, (bf16*)(F.ws + WS_KI), (float*)(F.ws + WS_WI)};
          epi::RepOrder<pg8::StaticOrder> Sr{So, So.c < So.nwg ? (So.nwg - So.c + So.G - 1) / So.G : 0, PMUL(2)};
          pg8::gemm_phase<epi::EpiProjIdx, epi::RepOrder<pg8::StaticOrder>, true, true>(F.lds + RING_OFF, g, Sr, E); }
    }
    SEAM(2);
    if (IN(3)) { F.ap = kargs();
        for (;;) { const int i = queue_next(F, CW_Q3 + 64 * rep); if (i >= 1024 * PMUL(3)) break; idx::index_unit(F, 1023 - (i & 1023)); }
        p3_norms(F);
        F.ap = kargs(); weight_items(F, CW_P0 + 16, W_EARLY, W_EARLY + W_LATE / 2);
        __syncthreads();
    }
    SEAM(3);
    if (IN(4)) { F.ap = kargs();
        float lam;
        { float a = 0.f, b = 0.f;
          for (int i = 0; i < 64; ++i) { a += FIN(F, 5)[i] * FIN(F, 6)[i]; b += FIN(F, 7)[i] * FIN(F, 8)[i]; }
          lam = __expf(a) - __expf(b) + LAM_INIT; }
#define DSA_LOOP() do { build_order(F, 1); \
            for (int i = queue_next(F, CW_Q4S + 64 * rep); i < 512 * PMUL(41); ) { \
                const int u = (int)(((LAS unsigned*)(F.lds + L_ORDER))[i & 511] & 0xffffu); \
                dsa_unit(F, (char*)lds, u >> 6, u & 63, CW_Q4S + 64 * rep); \
                __syncthreads(); i = __builtin_amdgcn_readfirstlane(*(LAS int*)(F.lds + L_QI)); } } while (0)
#ifndef NO_DSA
        if (F.bid & 1) DSA_LOOP();
#endif
#ifndef NO_DIFF
        build_order(F, 0);
        for (int i = queue_next(F, CW_Q4D + 64 * rep); i < 1024 * PMUL(40); ) {
            const int u = (int)(((LAS unsigned*)(F.lds + L_ORDER))[i & 1023] & 0xffffu);
            diff_unit(F, (char*)lds, (u >> 6) & 7, u & 63, u >> 9, CW_Q4D + 64 * rep);
            __syncthreads(); i = __builtin_amdgcn_readfirstlane(*(LAS int*)(F.lds + L_QI)); }
#endif
#ifndef NO_DSA
        if (!(F.bid & 1)) DSA_LOOP();
#endif
#undef DSA_LOOP
        F.ap = kargs(); weight_items(F, CW_P0 + 32, W_EARLY + W_LATE / 2, W_EARLY + W_LATE);
        GRID_BAR();
        p4c_combine(F, lam);
        __syncthreads();
    }
    SEAM(4);
    if (IN(5)) { F.ap = kargs();
        pg8::StaticOrder So; So.init(S, D, F.G, F.bid);
        { pg8::Gemm g{(const pg8::bf16_t*)(F.ws + WS_YA), (const pg8::bf16_t*)(F.ws + WS_WA), S, D, D / 2};
          epi::EpiGateA E{PROJ + 7 * PROJ_STRIDE, (float*)(F.ws + WS_T1)};
          pg8::gemm_phase<epi::EpiGateA, pg8::StaticOrder, true, true, true>(F.lds + RING_OFF, g, So, E); }
        __syncthreads();
        { pg8::Gemm g{(const pg8::bf16_t*)(F.ws + WS_YB), (const pg8::bf16_t*)(F.ws + WS_WB), S, D, D / 2};
          epi::EpiGateB E{PROJ + 8 * PROJ_STRIDE, (const float*)(F.ws + WS_T1), (unsigned char*)(F.ws + WS_MG)};
          pg8::gemm_phase<epi::EpiGateB, pg8::StaticOrder, true, true, true>(F.lds + RING_OFF, g, So, E); }
    }
    SEAM(5);
    if (IN(6)) { F.ap = kargs();
        pg8::Gemm g{(const pg8::bf16_t*)(F.ws + WS_MG), (const pg8::bf16_t*)(F.ws + WS_WO), S, D, D / 2}; pg8::StaticOrder So; So.init(S, D, F.G, F.bid);
        epi::EpiOut E{FIN(F, 0), (const float*)(F.ws + WS_SMALL) + 2048, (bf16*)(F.ws + WS_Y1)};
        pg8::gemm_phase<epi::EpiOut, pg8::StaticOrder, true, true, true>(F.lds + RING_OFF, g, So, E);
    }
    SEAM(6);
    if (IN(7)) { F.ap = kargs(); p7_ln_router(F); }
    SEAM(7);
    if (IN(9)) { F.ap = kargs();
        moe_tables(F);
        pg8::Gemm g{(const pg8::bf16_t*)(F.ws + WS_VB16), (const pg8::bf16_t*)(F.ws + WS_W1), MAXSLOT, NE * 2 * FF, D / 2};
        epi::MoeOrder So{(const LAS unsigned char*)(F.lds + L_TEXP), *(LAS int*)(F.lds + L_NT), 8, F.G, F.bid, (const int*)(F.ws + WS_IDXTOK), (const LAS unsigned*)(F.lds + L_OFF), (const LAS unsigned*)(F.lds + L_CNT)};
        epi::EpiMoe1 E{FIN(F, 18), (unsigned char*)(F.ws + WS_H)};
        const int tot1 = So.ntiles * So.nN; epi::RepOrder<epi::MoeOrder> Sr{So, So.c < tot1 ? (tot1 - So.c + So.G - 1) / So.G : 0, PMUL(9)};
        pg8::gemm_phase<epi::EpiMoe1, epi::RepOrder<epi::MoeOrder>, true, true, true, true>(F.lds + RING_OFF, g, Sr, E);
    }
    SEAM(9);
    if (IN(10)) { F.ap = kargs();
        moe_tables(F);
        pg8::Gemm g{(const pg8::bf16_t*)(F.ws + WS_H), (const pg8::bf16_t*)(F.ws + WS_W2), MAXSLOT, NE * D, FF / 2};
        epi::MoeOrder So{(const LAS unsigned char*)(F.lds + L_TEXP), *(LAS int*)(F.lds + L_NT), 4, F.G, F.bid, nullptr, (const LAS unsigned*)(F.lds + L_OFF), (const LAS unsigned*)(F.lds + L_CNT)};
        epi::EpiMoe2 E{FIN(F, 20), (const float*)(F.ws + WS_IDXW), (const LAS unsigned*)(F.lds + L_OFF), (unsigned char*)(F.ws + WS_OUT2)};
        const int tot2 = So.ntiles * So.nN; epi::RepOrder<epi::MoeOrder> Sr{So, So.c < tot2 ? (tot2 - So.c + So.G - 1) / So.G : 0, PMUL(10)};
        pg8::gemm_phase<epi::EpiMoe2, epi::RepOrder<epi::MoeOrder>, true, true, true>(F.lds + RING_OFF, g, Sr, E);
    }
    SEAM(10);
    if (IN(11)) { F.ap = kargs(); p11_final(F); }
#undef IN
#undef SEAM
}

extern "C" void kernel_launch(void* const* d_in, const int* in_sizes, int n_in, void* d_out, int out_size, void* d_ws, size_t ws_size, hipStream_t stream) {
    static int grid = 0;
    if (grid == 0) {
        if (n_in != 23 || in_sizes[0] != S * D || out_size != S * D || ws_size < WS_END) {
            fprintf(stderr, "kernel_launch: shape mismatch: n_in %d in0 %d out %d ws %zu (need %zu)\n", n_in, n_in > 0 ? in_sizes[0] : -1, out_size, ws_size, (size_t)WS_END); grid = -1; return; }
        int dev = 0, cus = 0;
        if (hipGetDevice(&dev) != hipSuccess || hipDeviceGetAttribute(&cus, hipDeviceAttributeMultiprocessorCount, dev) != hipSuccess) { fprintf(stderr, "kernel_launch: device query failed\n"); grid = -1; return; }
        if (hipFuncSetAttribute((const void*)block_fwd, hipFuncAttributeMaxDynamicSharedMemorySize, LDS_BYTES) != hipSuccess) { fprintf(stderr, "kernel_launch: hipFuncSetAttribute failed\n"); grid = -1; return; }
        int per_cu = 0;
        if (hipOccupancyMaxActiveBlocksPerMultiprocessor(&per_cu, (const void*)block_fwd, NWAVES * 64, LDS_BYTES) != hipSuccess || per_cu < 1)
            fprintf(stderr, "kernel_launch: note: occupancy query reports %d workgroups per CU\n", per_cu);
        (void)hipGetLastError();
        if (cus != 256) { fprintf(stderr, "kernel_launch: built for 256 CUs, device has %d\n", cus); grid = -1; return; }
        grid = 256;
    }
    if (grid < 0) return;
    if (hipMemsetAsync((char*)d_ws + WS_CTL, 0, CTL_ZERO_BYTES, stream) != hipSuccess) { fprintf(stderr, "kernel_launch: memset failed\n"); return; }
    Args a{};
    for (int i = 0; i < 23; ++i) a.in[i] = (const float*)d_in[i];
    a.out = (float*)d_out; a.ws = (unsigned char*)d_ws;
#if MK_ONE_LAUNCH
    a.ph_lo = 0; a.ph_hi = NPHASE;
    hipLaunchKernelGGL(block_fwd, dim3(grid), dim3(NWAVES * 64), LDS_BYTES, stream, a);
#else
    for (int p = 0; p < NPHASE; ++p) { a.ph_lo = p; a.ph_hi = p + 1;
        hipLaunchKernelGGL(block_fwd, dim3(grid), dim3(NWAVES * 64), LDS_BYTES, stream, a); }
#endif
    const hipError_t le = hipPeekAtLastError();
    if (le != hipSuccess) fprintf(stderr, "kernel_launch: launch failed: %s\n", hipGetErrorName(le));
}
```
